# Optimizing an MI355X kernel written in HIP

```python
import jax
import jax.numpy as jnp
from jax import lax
import numpy as np

D_MODEL = 1024
BATCH = 2
SEQ = 8192
DEPTH = 2

EPS = 1e-6
ROPE_THETA = 10000.0
NEG_INF = -1e30
D_FF = 2816
N_BRANCH = 3
MIX_WIDTH = 512

MLA_HEADS = 8
MLA_Q_RANK = 256
MLA_KV_RANK = 128
MLA_NOPE = 64
MLA_ROPE = 32
MLA_V = 64
MLA_QK = MLA_NOPE + MLA_ROPE
ATTN_BLOCK_Q = 128

GDN_HEADS = 4
GDN_DK = 128
GDN_DV = 128
GDN_CONV = 4
GDN_CHUNK = 64

MOBA_HEADS = 8
MOBA_DH = 64
MOBA_BLOCK = 256
MOBA_TOPK = 3
MOBA_QCHUNK = 64

IN_SPLITS = (
    MLA_Q_RANK,
    MLA_KV_RANK,
    MLA_ROPE,
    GDN_HEADS * GDN_DK,
    GDN_HEADS * GDN_DK,
    GDN_HEADS * GDN_DV,
    GDN_HEADS,
    GDN_HEADS,
    GDN_HEADS * GDN_DV,
    3 * MOBA_HEADS * MOBA_DH,
    N_BRANCH * D_MODEL,
)
D_IN = sum(IN_SPLITS)

kernel_name = 'hybrid_mla_gdn_moba_macaron'


def split_cols(t, sizes):
    offs = np.cumsum(sizes)[:-1].tolist()
    return jnp.split(t, offs, axis=-1)


def rms_norm(x, g):
    xf = x.astype(jnp.float32)
    y = xf * lax.rsqrt(jnp.mean(xf * xf, axis=-1, keepdims=True) + EPS)
    return (y * g.astype(jnp.float32)).astype(x.dtype)


def l2norm(x):
    return x * lax.rsqrt(jnp.sum(x * x, axis=-1, keepdims=True) + EPS)


def rope(x, pos):
    d = x.shape[-1]
    half = d // 2
    inv_freq = ROPE_THETA ** (-jnp.arange(half, dtype=jnp.float32) * 2.0 / d)
    ang = pos.astype(jnp.float32)[:, None] * inv_freq[None, :]
    cos = jnp.cos(ang)[None, :, None, :]
    sin = jnp.sin(ang)[None, :, None, :]
    xf = x.astype(jnp.float32)
    x1, x2 = xf[..., :half], xf[..., half:]
    return jnp.concatenate([x1 * cos - x2 * sin, x2 * cos + x1 * sin], axis=-1).astype(x.dtype)


def swiglu(h, w_in, w_out):
    gate, up = jnp.split(h @ w_in, 2, axis=-1)
    return (jax.nn.silu(gate) * up) @ w_out


def causal_dwconv(x, w):
    c = x.shape[-1]
    k = w.shape[0]
    return lax.conv_general_dilated(
        x, w[:, None, :].astype(x.dtype), window_strides=(1,), padding=[(k - 1, 0)],
        dimension_numbers=('NWC', 'WIO', 'NWC'), feature_group_count=c)


def causal_attention_blocked(q, k, v, scale):
    b, h, s, dk = q.shape
    nb = s // ATTN_BLOCK_Q
    qb = jnp.moveaxis(q.reshape(b, h, nb, ATTN_BLOCK_Q, dk), 2, 0)
    k_pos = jnp.arange(s)

    def one_block(args):
        i, q_i = args
        logits = jnp.einsum('bhqd,bhkd->bhqk', q_i, k, preferred_element_type=jnp.float32) * scale
        q_pos = i * ATTN_BLOCK_Q + jnp.arange(ATTN_BLOCK_Q)
        logits = jnp.where(k_pos[None, :] <= q_pos[:, None], logits, NEG_INF)
        p = jax.nn.softmax(logits, axis=-1).astype(v.dtype)
        return jnp.einsum('bhqk,bhkd->bhqd', p, v)

    o = lax.map(one_block, (jnp.arange(nb), qb))
    return jnp.moveaxis(o, 0, 2).reshape(b, h, s, v.shape[-1])


def mla_branch(c_q, c_kv, k_rope, pos, cq_norm, ckv_norm, w_uq, w_ukv, q_norm, k_norm):
    b, s, _ = c_q.shape
    h = MLA_HEADS
    q = (rms_norm(c_q, cq_norm) @ w_uq).reshape(b, s, h, MLA_QK)
    kv = (rms_norm(c_kv, ckv_norm) @ w_ukv).reshape(b, s, h, MLA_NOPE + MLA_V)
    k_nope, v = kv[..., :MLA_NOPE], kv[..., MLA_NOPE:]
    k = jnp.concatenate([k_nope, jnp.broadcast_to(k_rope[:, :, None, :], (b, s, h, MLA_ROPE))], axis=-1)
    q = rms_norm(q, q_norm)
    k = rms_norm(k, k_norm)
    q = jnp.concatenate([q[..., :MLA_NOPE], rope(q[..., MLA_NOPE:], pos)], axis=-1)
    k = jnp.concatenate([k[..., :MLA_NOPE], rope(k[..., MLA_NOPE:], pos)], axis=-1)
    to_bhsd = lambda t: jnp.transpose(t, (0, 2, 1, 3))
    o = causal_attention_blocked(to_bhsd(q), to_bhsd(k), to_bhsd(v), MLA_QK ** -0.5)
    return jnp.transpose(o, (0, 2, 1, 3)).reshape(b, s, h * MLA_V)


def gated_delta_rule_chunked(q, k, v, beta, g):
    b, s, h, dk = q.shape
    dv = v.shape[-1]
    c = GDN_CHUNK
    n = s // c

    def chunks(t):
        return jnp.moveaxis(t.reshape((b, n, c, h) + t.shape[3:]), 3, 1)

    q, k, v, beta, g = (chunks(t) for t in (q, k, v, beta, g))
    gcum = jnp.cumsum(g, axis=-1)
    tril = jnp.tril(jnp.ones((c, c), dtype=bool))
    strict = jnp.tril(jnp.ones((c, c), dtype=bool), -1)
    decay = jnp.exp(jnp.where(tril, gcum[..., :, None] - gcum[..., None, :], NEG_INF))
    k_beta = k * beta[..., None]
    a = jnp.where(strict, jnp.einsum('bhnid,bhnjd->bhnij', k_beta, k) * decay, 0.0)
    eye = jnp.eye(c, dtype=q.dtype)
    rhs = jnp.concatenate([v * beta[..., None], k_beta * jnp.exp(gcum)[..., None]], axis=-1)
    sol = lax.linalg.triangular_solve(eye + a, rhs, left_side=True, lower=True, unit_diagonal=True)
    u, w = sol[..., :dv], sol[..., dv:]
    qk = jnp.einsum('bhnid,bhnjd->bhnij', q, k) * decay
    q_dec = q * jnp.exp(gcum)[..., None]
    g_last = gcum[..., -1]
    k_dec = k * jnp.exp(g_last[..., None] - gcum)[..., None]

    def step(state, xs):
        q_i, w_i, u_i, qk_i, k_i, gl_i = xs
        v_new = u_i - jnp.einsum('bhcd,bhde->bhce', w_i, state)
        o_i = jnp.einsum('bhcd,bhde->bhce', q_i, state) + jnp.einsum('bhcj,bhje->bhce', qk_i, v_new)
        state = state * jnp.exp(gl_i)[..., None, None] + jnp.einsum('bhcd,bhce->bhde', k_i, v_new)
        return state, o_i

    xs = tuple(jnp.moveaxis(t, 2, 0) for t in (q_dec, w, u, qk, k_dec, g_last))
    state0 = jnp.zeros((b, h, dk, dv), q.dtype)
    _, o = lax.scan(step, state0, xs)
    return jnp.transpose(o, (1, 0, 3, 2, 4)).reshape(b, s, h, dv)


def gdn_branch(q, k, v, b_logit, a_logit, z, conv_w, a_log, dt_bias, out_norm):
    b, s, _ = q.shape
    f32 = jnp.float32
    qkv = jax.nn.silu(causal_dwconv(jnp.concatenate([q, k, v], axis=-1), conv_w)).astype(f32)
    q, k, v = jnp.split(qkv, [GDN_HEADS * GDN_DK, 2 * GDN_HEADS * GDN_DK], axis=-1)
    q = l2norm(q.reshape(b, s, GDN_HEADS, GDN_DK)) * (GDN_DK ** -0.5)
    k = l2norm(k.reshape(b, s, GDN_HEADS, GDN_DK))
    v = v.reshape(b, s, GDN_HEADS, GDN_DV)
    beta = jax.nn.sigmoid(b_logit.astype(f32))
    g = -jnp.exp(a_log.astype(f32)) * jax.nn.softplus(a_logit.astype(f32) + dt_bias.astype(f32))
    o = gated_delta_rule_chunked(q, k, v, beta, g)
    o = rms_norm(o, out_norm).astype(z.dtype) * jax.nn.silu(z.reshape(b, s, GDN_HEADS, GDN_DV))
    return o.reshape(b, s, GDN_HEADS * GDN_DV)


def moba_branch(qkv, pos, q_norm, k_norm):
    b, s, _ = qkv.shape
    h, dh, bs = MOBA_HEADS, MOBA_DH, MOBA_BLOCK
    q, k, v = (t.reshape(b, s, h, dh) for t in jnp.split(qkv, 3, axis=-1))
    q = rope(rms_norm(q, q_norm), pos)
    k = rope(rms_norm(k, k_norm), pos)
    nb = -(-s // bs)
    s_pad = nb * bs

    def prep(t):
        return jnp.pad(jnp.transpose(t, (0, 2, 1, 3)), ((0, 0), (0, 0), (0, s_pad - s), (0, 0)))

    q, k, v = prep(q), prep(k), prep(v)
    kb = k.reshape(b, h, nb, bs, dh)
    vb = v.reshape(b, h, nb, bs, dh)
    k_mean = jnp.mean(kb.astype(jnp.float32), axis=3)
    gate = jnp.einsum('bhsd,bhnd->bhsn', q.astype(jnp.float32), k_mean)
    q_blk = jnp.arange(s_pad) // bs
    gate = jnp.where(jnp.arange(nb)[None, :] < q_blk[:, None], gate, NEG_INF)
    n_sel = min(MOBA_TOPK, nb)
    _, sel = lax.top_k(gate, n_sel)
    sel_valid = sel < q_blk[:, None]
    scale = dh ** -0.5
    b_idx = jnp.arange(b)[:, None, None, None]
    h_idx = jnp.arange(h)[None, :, None, None]
    key_off = jnp.arange(bs)

    def one_chunk(ci):
        start = ci * MOBA_QCHUNK
        q_c = lax.dynamic_slice_in_dim(q, start, MOBA_QCHUNK, axis=2)
        sel_c = lax.dynamic_slice_in_dim(sel, start, MOBA_QCHUNK, axis=2)
        valid_c = lax.dynamic_slice_in_dim(sel_valid, start, MOBA_QCHUNK, axis=2)
        k_sel = kb[b_idx, h_idx, sel_c]
        v_sel = vb[b_idx, h_idx, sel_c]
        s_sel = jnp.einsum('bhqd,bhqnkd->bhqnk', q_c, k_sel, preferred_element_type=jnp.float32) * scale
        s_sel = jnp.where(valid_c[..., None], s_sel, NEG_INF)
        j = start // bs
        k_own = lax.dynamic_index_in_dim(kb, j, axis=2, keepdims=False)
        v_own = lax.dynamic_index_in_dim(vb, j, axis=2, keepdims=False)
        s_own = jnp.einsum('bhqd,bhkd->bhqk', q_c, k_own, preferred_element_type=jnp.float32) * scale
        q_pos = start + jnp.arange(MOBA_QCHUNK)
        k_pos = j * bs + key_off
        s_own = jnp.where(k_pos[None, :] <= q_pos[:, None], s_own, NEG_INF)
        logits = jnp.concatenate([s_sel.reshape(b, h, MOBA_QCHUNK, n_sel * bs), s_own], axis=-1)
        p = jax.nn.softmax(logits, axis=-1).astype(v.dtype)
        p_sel = p[..., :n_sel * bs].reshape(b, h, MOBA_QCHUNK, n_sel, bs)
        p_own = p[..., n_sel * bs:]
        return (jnp.einsum('bhqnk,bhqnkd->bhqd', p_sel, v_sel)
                + jnp.einsum('bhqk,bhkd->bhqd', p_own, v_own))

    o = lax.map(one_chunk, jnp.arange(s_pad // MOBA_QCHUNK))
    o = jnp.transpose(o, (1, 0, 3, 2, 4)).reshape(b, s_pad, h * dh)
    return o[:, :s]


def setup_inputs(seed: int = 0) -> dict:
    key = jax.random.key(seed)
    ks = jax.random.split(key, 24)
    L = DEPTH
    f32 = jnp.float32

    def nrm(k, shape, fan_in):
        return jax.random.normal(k, shape, f32) * (fan_in ** -0.5)

    def gain(k, shape):
        return 1.0 + 0.02 * jax.random.normal(k, shape, f32)

    dt = jnp.exp(jax.random.uniform(ks[14], (L, GDN_HEADS), f32, np.log(1e-3), np.log(1e-1)))
    return {
        'x': jax.random.normal(ks[0], (BATCH, SEQ, D_MODEL), f32),
        'ffa_norm': gain(ks[1], (L, D_MODEL)),
        'ffa_w_in': nrm(ks[2], (L, D_MODEL, 2 * D_FF), D_MODEL),
        'ffa_w_out': nrm(ks[3], (L, D_FF, D_MODEL), D_FF),
        'mix_norm': gain(ks[4], (L, D_MODEL)),
        'w_in': nrm(ks[5], (L, D_MODEL, D_IN), D_MODEL),
        'mla_cq_norm': gain(ks[6], (L, MLA_Q_RANK)),
        'mla_ckv_norm': gain(ks[7], (L, MLA_KV_RANK)),
        'mla_w_uq': nrm(ks[8], (L, MLA_Q_RANK, MLA_HEADS * MLA_QK), MLA_Q_RANK),
        'mla_w_ukv': nrm(ks[9], (L, MLA_KV_RANK, MLA_HEADS * (MLA_NOPE + MLA_V)), MLA_KV_RANK),
        'mla_q_norm': gain(ks[10], (L, MLA_QK)),
        'mla_k_norm': gain(ks[11], (L, MLA_QK)),
        'gdn_conv': nrm(ks[12], (L, GDN_CONV, GDN_HEADS * (2 * GDN_DK + GDN_DV)), GDN_CONV),
        'gdn_a_log': jnp.log(jax.random.uniform(ks[13], (L, GDN_HEADS), f32, 1.0, 16.0)),
        'gdn_dt_bias': dt + jnp.log(-jnp.expm1(-dt)),
        'gdn_out_norm': gain(ks[15], (L, GDN_DV)),
        'moba_q_norm': gain(ks[16], (L, MOBA_DH)),
        'moba_k_norm': gain(ks[17], (L, MOBA_DH)),
        'w_branch': nrm(ks[18], (L, N_BRANCH, MIX_WIDTH, D_MODEL), MIX_WIDTH),
        'w_out': nrm(ks[19], (L, D_MODEL, D_MODEL), D_MODEL),
        'ffb_norm': gain(ks[20], (L, D_MODEL)),
        'ffb_w_in': nrm(ks[21], (L, D_MODEL, 2 * D_FF), D_MODEL),
        'ffb_w_out': nrm(ks[22], (L, D_FF, D_MODEL), D_FF),
    }


def reference(x, ffa_norm, ffa_w_in, ffa_w_out, mix_norm, w_in, mla_cq_norm, mla_ckv_norm,
              mla_w_uq, mla_w_ukv, mla_q_norm, mla_k_norm, gdn_conv, gdn_a_log, gdn_dt_bias,
              gdn_out_norm, moba_q_norm, moba_k_norm, w_branch, w_out, ffb_norm, ffb_w_in,
              ffb_w_out):
    b, s, _ = x.shape
    pos = jnp.arange(s, dtype=jnp.int32)
    for l in range(DEPTH):
        x = x + 0.5 * swiglu(rms_norm(x, ffa_norm[l]), ffa_w_in[l], ffa_w_out[l])
        h = rms_norm(x, mix_norm[l])
        (c_q, c_kv, k_rope, g_q, g_k, g_v, g_b, g_a, g_z, m_qkv, gate_logits) = split_cols(h @ w_in[l], IN_SPLITS)
        o_mla = mla_branch(c_q, c_kv, k_rope, pos, mla_cq_norm[l], mla_ckv_norm[l], mla_w_uq[l],
                           mla_w_ukv[l], mla_q_norm[l], mla_k_norm[l])
        o_gdn = gdn_branch(g_q, g_k, g_v, g_b, g_a, g_z, gdn_conv[l], gdn_a_log[l], gdn_dt_bias[l],
                           gdn_out_norm[l])
        o_moba = moba_branch(m_qkv, pos, moba_q_norm[l], moba_k_norm[l])
        branches = jnp.stack([o_mla, o_gdn, o_moba], axis=2)
        up = jnp.einsum('bsnw,nwd->bsnd', branches, w_branch[l])
        gates = jax.nn.sigmoid(gate_logits.reshape(b, s, N_BRANCH, D_MODEL))
        x = x + jnp.sum(gates * up, axis=2) @ w_out[l]
        x = x + 0.5 * swiglu(rms_norm(x, ffb_norm[l]), ffb_w_in[l], ffb_w_out[l])
    return x
```

```cpp
#include <hip/hip_runtime.h>
#include <hip/hip_cooperative_groups.h>
#include <cstdio>
#include <cstdint>
namespace cg = cooperative_groups;

#ifndef REP_Q
#define REP_Q -1
#endif
#ifndef REP_MODE
#define REP_MODE 0
#endif
#ifndef SCAN_VARIANT
#define SCAN_VARIANT 0
#endif
#ifndef EXTRA_SYNC
#define EXTRA_SYNC 0
#endif
#ifndef ONE_LAUNCH
#define ONE_LAUNCH 1
#endif

typedef unsigned short bf16_t;
typedef short bf16x8 __attribute__((ext_vector_type(8)));
typedef short bf16x4 __attribute__((ext_vector_type(4)));
typedef float f32x4 __attribute__((ext_vector_type(4)));
typedef float f32x16 __attribute__((ext_vector_type(16)));
typedef unsigned u32x4 __attribute__((ext_vector_type(4)));
typedef unsigned u32x2 __attribute__((ext_vector_type(2)));
#define LAS __attribute__((address_space(3)))

constexpr int T = 16384, SEQ = 8192, DM = 1024, FF = 2816, FF2 = 5632, DIN = 7080;
constexpr int PA = 4096;
constexpr int NG = 3072;
constexpr int MR = 1792;
constexpr int BR = 1536;
constexpr int NT = 512;
constexpr int LDS_BYTES = 144 * 1024;
constexpr float EPS = 1e-6f;
constexpr float LOG2E = 1.4426950408889634f;
constexpr int C_CQ = 0, C_CKV = 256, C_KR = 384, C_GQ = 416, C_GK = 928, C_GV = 1440, C_GB = 1952, C_GA = 1956, C_GZ = 1960, C_MQ = 2472, C_MK = 2984, C_MV = 3496;

constexpr size_t AL(size_t x) { return (x + 255) & ~(size_t)255; }
constexpr size_t W_FFA_IN = 0;
constexpr size_t W_FFA_OUT = W_FFA_IN + (size_t)FF2 * DM * 2;
constexpr size_t W_INA = W_FFA_OUT + (size_t)DM * FF * 2;
constexpr size_t W_GATE = W_INA + (size_t)PA * DM * 2;
constexpr size_t W_MLA = W_GATE + (size_t)NG * DM * 2;
constexpr size_t W_BR = W_MLA + (size_t)MR * 384 * 2;
constexpr size_t W_OUT = W_BR + (size_t)DM * BR * 2;
constexpr size_t W_FFB_IN = W_OUT + (size_t)DM * DM * 2;
constexpr size_t W_FFB_OUT = W_FFB_IN + (size_t)FF2 * DM * 2;
constexpr size_t WS_XB = W_FFB_OUT + (size_t)DM * FF * 2;
constexpr size_t WS_SSQ = WS_XB + (size_t)T * DM * 2;
constexpr size_t WS_TAB64 = WS_SSQ + (size_t)T * 4 * 4;
constexpr size_t WS_TAB32 = WS_TAB64 + (size_t)SEQ * 32 * 8;
constexpr size_t WS_RQ = WS_TAB32 + (size_t)SEQ * 16 * 8;
constexpr size_t WS_RKV = WS_RQ + (size_t)SEQ * 4;
constexpr size_t WS_KMEAN = WS_RKV + (size_t)SEQ * 4;
constexpr size_t WS_MASK = WS_KMEAN + (size_t)8 * 32 * 64 * 4;
constexpr size_t WS_GLAST = WS_MASK + (size_t)8 * SEQ * 4;
constexpr size_t WS_CTR = WS_GLAST + (size_t)4 * 128 * 4;
constexpr size_t WS_PTRS = WS_CTR + 512;
constexpr size_t WS_BAR = AL(WS_CTR + 1024);
constexpr size_t WS_BAR_BYTES = 3456 * 4;
constexpr size_t WS_BIG = AL(WS_BAR + WS_BAR_BYTES);
constexpr size_t B_ACT = WS_BIG;
constexpr size_t B_BRANCH = WS_BIG;
constexpr size_t B_PROJ = B_BRANCH + (size_t)T * BR * 2;
constexpr size_t B_MLA = B_PROJ + (size_t)SEQ * PA * 2;
constexpr size_t B_KROPE = B_MLA + (size_t)SEQ * MR * 2;
constexpr size_t B_GU = B_KROPE + (size_t)SEQ * 8 * 32 * 2;
constexpr size_t B_GW = B_GU + (size_t)SEQ * 512 * 2;
constexpr size_t B_GQD = B_GW + (size_t)SEQ * 512 * 2;
constexpr size_t B_GKT = B_GQD + (size_t)SEQ * 512 * 2;
constexpr size_t B_GQK = B_GKT + (size_t)SEQ * 512 * 2;
constexpr size_t B_END1 = B_GQK + (size_t)4 * 128 * 64 * 64 * 2;
constexpr size_t B_GATES = B_PROJ;
constexpr size_t B_MERGED = B_GATES + (size_t)T * NG * 2;
constexpr size_t B_END2 = B_MERGED + (size_t)T * DM * 2;
constexpr size_t B_END3 = B_ACT + (size_t)T * FF * 2;
constexpr size_t WS_NEED = (B_END1 > B_END2 ? (B_END1 > B_END3 ? B_END1 : B_END3) : (B_END2 > B_END3 ? B_END2 : B_END3));

struct Args {
    const float* in[23];
    float* out;
    unsigned char* ws;
    int ph_lo, ph_hi;
};
template <class T> __device__ __forceinline__ T* as_global(T* p) { return (T*)(__attribute__((address_space(1))) T*)p; }
struct Ctx { const float* const* in_; float* out; unsigned char* ws;
    __device__ __forceinline__ const float* in(int i) const { return as_global(in_[i]); } };
enum { I_X = 0, I_FFA_NORM, I_FFA_WIN, I_FFA_WOUT, I_MIX_NORM, I_WIN, I_CQ_NORM, I_CKV_NORM, I_WUQ, I_WUKV, I_QN, I_KN, I_CONV, I_ALOG, I_DTB, I_ONORM,
       I_MQN, I_MKN, I_WBR, I_WOUT, I_FFB_NORM, I_FFB_WIN, I_FFB_WOUT };

__device__ __forceinline__ float bf2f(bf16_t h) { return __uint_as_float(((unsigned)h) << 16); }
typedef __bf16 bf16x2_t __attribute__((ext_vector_type(2)));
typedef float f32x2_t __attribute__((ext_vector_type(2)));
__device__ __forceinline__ unsigned cvt_pk(float lo, float hi) { f32x2_t v = {lo, hi}; bf16x2_t b = __builtin_convertvector(v, bf16x2_t); return __builtin_bit_cast(unsigned, b); }
__device__ __forceinline__ bf16_t f2bf(float f) { return (bf16_t)(cvt_pk(f, 0.f) & 0xffffu); }
__device__ __forceinline__ float lo_bf(unsigned u) { return __uint_as_float(u << 16); }
__device__ __forceinline__ float hi_bf(unsigned u) { return __uint_as_float(u & 0xffff0000u); }
__device__ __forceinline__ float wave_sum(float v) {
#pragma unroll
    for (int o = 32; o > 0; o >>= 1) v += __shfl_xor(v, o);
    return v;
}
__device__ __forceinline__ float sigmoidf_(float x) { return __builtin_amdgcn_rcpf(1.f + __builtin_amdgcn_exp2f(-1.4426950408889634f * x)); }
__device__ __forceinline__ float siluf_(float x) { return x * __builtin_amdgcn_rcpf(1.f + __builtin_amdgcn_exp2f(-1.4426950408889634f * x)); }

__device__ __forceinline__ int fresh_tid() { int t; asm volatile("v_mov_b32 %0, %1" : "=v"(t) : "v"(threadIdx.x)); return t; }
__device__ __forceinline__ int fresh_bid() { int t; asm volatile("s_mov_b32 %0, %1" : "=s"(t) : "s"(blockIdx.x)); return t; }
constexpr int BK = 64, HALF = 128, HTB = HALF * BK * 2;
__device__ __forceinline__ int lds_byte(int r, int c) {
    int st = (r >> 4) * 2 + (c >> 5), rr = r & 15, cc = c & 31, ob = rr * 64 + cc * 2;
    return st * 1024 + (ob ^ (((ob >> 9) & 1) << 5));
}
__device__ __forceinline__ void stage_rc(int b, int& R, int& C) {
    int st = b / 1024, sb = b % 1024, swz = sb ^ (((sb >> 9) & 1) << 5);
    R = (st >> 1) * 16 + swz / 64; C = (st & 1) * 32 + (swz % 64) / 2;
}

typedef f32x4 Acc[2][2][4][2];

template <bool PRE = false>
__device__ __forceinline__ void gemm_kloop(Acc& acc, const bf16_t* __restrict__ A, int lda, const bf16_t* __restrict__ Bt, int ldb,
                                           int brow, int bcol, int nt, LAS unsigned char* lds) {
    const int tid = fresh_tid();
    const int wid = tid >> 6, lane = tid & 63, wr = wid >> 2, wc = wid & 3, fr = lane & 15, fq = lane >> 4;
    const int wvu = __builtin_amdgcn_readfirstlane(tid >> 6);
    unsigned offA, offB;
    { int _r, _c; stage_rc(tid * 16, _r, _c); offA = (unsigned)(_r * lda + _c) * 2u; offB = (unsigned)(_r * ldb + _c) * 2u; }
#define SAo(b, h) (((b) * 2 + (h)) * HTB)
#define SBo(b, h) ((4 + (b) * 2 + (h)) * HTB)
#define STAGE(Poff, BASE, LD, br, kt, OFF) do { int _kt = (kt), _wv = wvu; asm volatile("" : "+s"(_kt), "+s"(_wv));     \
    _Pragma("unroll") for (int _i = 0; _i < 2; ++_i) { const char* _g = (const char*)((BASE) + (long)((br) + _i * 64) * (LD) + (long)_kt * BK); \
      __builtin_amdgcn_global_load_lds((const unsigned*)(_g + OFF), (LAS unsigned*)(lds + (Poff) + _wv * 1024 + _i * 8192), 16, 0, 0); } } while (0)
#define LDA(dst, b, h) _Pragma("unroll") for (int m = 0; m < 4; ++m) _Pragma("unroll") for (int k = 0; k < 2; ++k) \
    dst[m][k] = *reinterpret_cast<const LAS bf16x8*>(lds + SAo(b, h) + lds_byte(wr * 64 + m * 16 + fr, k * 32 + fq * 8))
#define LDB(dst, b, h) _Pragma("unroll") for (int n = 0; n < 2; ++n) _Pragma("unroll") for (int k = 0; k < 2; ++k) \
    dst[n][k] = *reinterpret_cast<const LAS bf16x8*>(lds + SBo(b, h) + lds_byte(wc * 32 + n * 16 + fr, k * 32 + fq * 8))
#define MMA(ai, bj, At_, Bt_) do { __builtin_amdgcn_s_setprio(1); \
    _Pragma("unroll") for (int m = 0; m < 4; ++m) _Pragma("unroll") for (int n = 0; n < 2; ++n) _Pragma("unroll") for (int k = 0; k < 2; ++k) \
      acc[ai][bj][m][n] = __builtin_amdgcn_mfma_f32_16x16x32_bf16(Bt_[n][k], At_[m][k], acc[ai][bj][m][n], 0, 0, 0); \
    __builtin_amdgcn_s_setprio(0); } while (0)
#define WAIT_V(n) asm volatile("s_waitcnt vmcnt(" #n ")" ::: "memory")
#define WAIT_L(n) asm volatile("s_waitcnt lgkmcnt(" #n ")" ::: "memory")
#define BAR __builtin_amdgcn_s_barrier()
#define SCHED __builtin_amdgcn_sched_barrier(0)
    bf16x8 At[4][2], B0[2][2], B1[2][2];
    if (!PRE) {
    STAGE(SBo(0, 0), Bt, ldb, bcol, 0, offB); STAGE(SAo(0, 0), A, lda, brow, 0, offA);
    STAGE(SBo(0, 1), Bt, ldb, bcol + HALF, 0, offB); STAGE(SAo(0, 1), A, lda, brow + HALF, 0, offA);
    }
    if (wr == 1) BAR;
    WAIT_V(4); BAR;
    STAGE(SBo(1, 0), Bt, ldb, bcol, 1, offB); STAGE(SAo(1, 0), A, lda, brow, 1, offA); STAGE(SBo(1, 1), Bt, ldb, bcol + HALF, 1, offB);
    WAIT_V(6); BAR;
    for (int t = 0; t < nt - 2; t += 2) {
        LDB(B0, 0, 0); SCHED; LDA(At, 0, 0); STAGE(SAo(1, 1), A, lda, brow + HALF, t + 1, offA);
        WAIT_L(8); BAR; WAIT_L(0); MMA(0, 0, At, B0); BAR; SCHED;
        LDB(B1, 0, 1); STAGE(SBo(0, 0), Bt, ldb, bcol, t + 2, offB);
        BAR; WAIT_L(0); MMA(0, 1, At, B1); BAR;
        LDA(At, 0, 1); STAGE(SAo(0, 0), A, lda, brow, t + 2, offA);
        BAR; WAIT_L(0); MMA(1, 0, At, B0); BAR; SCHED;
        STAGE(SBo(0, 1), Bt, ldb, bcol + HALF, t + 2, offB);
        WAIT_V(6); BAR; MMA(1, 1, At, B1); BAR;
        LDB(B0, 1, 0); SCHED; LDA(At, 1, 0); STAGE(SAo(0, 1), A, lda, brow + HALF, t + 2, offA);
        WAIT_L(8); BAR; WAIT_L(0); MMA(0, 0, At, B0); BAR; SCHED;
        LDB(B1, 1, 1); STAGE(SBo(1, 0), Bt, ldb, bcol, t + 3, offB);
        BAR; WAIT_L(0); MMA(0, 1, At, B1); BAR;
        LDA(At, 1, 1); STAGE(SAo(1, 0), A, lda, brow, t + 3, offA);
        BAR; WAIT_L(0); MMA(1, 0, At, B0); BAR; SCHED;
        STAGE(SBo(1, 1), Bt, ldb, bcol + HALF, t + 3, offB);
        WAIT_V(6); BAR; MMA(1, 1, At, B1); BAR;
    }
    { LDB(B0, 0, 0); LDA(At, 0, 0); STAGE(SAo(1, 1), A, lda, brow + HALF, nt - 1, offA);
      BAR; WAIT_L(0); MMA(0, 0, At, B0); BAR;
      LDB(B1, 0, 1); BAR; WAIT_L(0); MMA(0, 1, At, B1); BAR;
      LDA(At, 0, 1); WAIT_V(4); BAR; WAIT_L(0); MMA(1, 0, At, B0); MMA(1, 1, At, B1); BAR; }
    { LDB(B0, 1, 0); LDA(At, 1, 0); WAIT_V(2); BAR; WAIT_L(0); MMA(0, 0, At, B0); BAR;
      LDB(B1, 1, 1); WAIT_V(0); BAR; WAIT_L(0); MMA(0, 1, At, B1); BAR;
      LDA(At, 1, 1); BAR; WAIT_L(0); MMA(1, 0, At, B0); MMA(1, 1, At, B1); BAR; }
    if (wr == 0) BAR;
}

__device__ __forceinline__ void gemm_stage_first(const bf16_t* __restrict__ A, int lda, const bf16_t* __restrict__ Bt, int ldb, int brow, int bcol, LAS unsigned char* lds) {
    const int tid = fresh_tid();
    const int wvu = __builtin_amdgcn_readfirstlane(tid >> 6);
    unsigned offA, offB;
    { int _r, _c; stage_rc(tid * 16, _r, _c); offA = (unsigned)(_r * lda + _c) * 2u; offB = (unsigned)(_r * ldb + _c) * 2u; }
    STAGE(SBo(0, 0), Bt, ldb, bcol, 0, offB); STAGE(SAo(0, 0), A, lda, brow, 0, offA);
    STAGE(SBo(0, 1), Bt, ldb, bcol + HALF, 0, offB); STAGE(SAo(0, 1), A, lda, brow + HALF, 0, offA);
}

#define ACC_ZERO(acc) _Pragma("unroll") for (int _a = 0; _a < 2; ++_a) _Pragma("unroll") for (int _b = 0; _b < 2; ++_b) _Pragma("unroll") for (int _m = 0; _m < 4; ++_m) \
    _Pragma("unroll") for (int _n = 0; _n < 2; ++_n) acc[_a][_b][_m][_n] = (f32x4){0.f, 0.f, 0.f, 0.f}

struct TileIdx { int tid, wid, lane, wr, wc, fr, fq; };
__device__ __forceinline__ TileIdx tile_idx() { TileIdx t; t.tid = fresh_tid(); t.wid = t.tid >> 6; t.lane = t.tid & 63; t.wr = t.wid >> 2; t.wc = t.wid & 3; t.fr = t.lane & 15; t.fq = t.lane >> 4; return t; }

__device__ __forceinline__ float rstd_from_ssq(const float* ssq, int row) {
    f32x4 s = *(const f32x4*)(ssq + (size_t)row * 4);
    return rsqrtf((s[0] + s[1] + s[2] + s[3]) * (1.f / 1024.f) + EPS);
}

__device__ __forceinline__ void epi_swiglu(Acc& acc, int pm, int pn, const float* ssq, bf16_t* act) {
    TileIdx t = tile_idx();
    float rsv[2][4];
#pragma unroll
    for (int ai = 0; ai < 2; ++ai)
#pragma unroll
        for (int m = 0; m < 4; ++m) rsv[ai][m] = rstd_from_ssq(ssq, pm * 256 + ai * 128 + t.wr * 64 + m * 16 + t.fr);
#pragma unroll
    for (int ai = 0; ai < 2; ++ai)
#pragma unroll
        for (int m = 0; m < 4; ++m) {
            int row = pm * 256 + ai * 128 + t.wr * 64 + m * 16 + t.fr;
            float rs = rsv[ai][m];
#pragma unroll
            for (int n = 0; n < 2; ++n) {
                float o[4];
#pragma unroll
                for (int j = 0; j < 4; ++j) { float g = acc[ai][0][m][n][j] * rs, u = acc[ai][1][m][n][j] * rs; o[j] = siluf_(g) * u; }
                u32x2 w; w[0] = cvt_pk(o[0], o[1]); w[1] = cvt_pk(o[2], o[3]);
                *(u32x2*)(act + (size_t)row * FF + pn * 128 + t.wc * 32 + n * 16 + t.fq * 4) = w;
            }
        }
}
__device__ __forceinline__ void epi_resid(Acc& acc, int pm, int pn, const float* xsrc, float* xdst, bf16_t* xb, float* ssq, float alpha, LAS unsigned char* lds) {
    TileIdx t = tile_idx();
    LAS float* red = (LAS float*)lds;
#pragma unroll
    for (int ai = 0; ai < 2; ++ai)
#pragma unroll
        for (int mp = 0; mp < 2; ++mp) {
            f32x4 xs[2][2][2];
#pragma unroll
            for (int mm = 0; mm < 2; ++mm)
#pragma unroll
                for (int bj = 0; bj < 2; ++bj)
#pragma unroll
                    for (int n = 0; n < 2; ++n) {
                        const int row = pm * 256 + ai * 128 + t.wr * 64 + (mp * 2 + mm) * 16 + t.fr;
                        xs[mm][bj][n] = *(const f32x4*)(xsrc + (size_t)row * DM + pn * 256 + bj * 128 + t.wc * 32 + n * 16 + t.fq * 4);
                    }
#pragma unroll
            for (int mm = 0; mm < 2; ++mm) {
                const int m = mp * 2 + mm;
                const int rl = ai * 128 + t.wr * 64 + m * 16 + t.fr;
                const int row = pm * 256 + rl;
                float ss = 0.f;
#pragma unroll
                for (int bj = 0; bj < 2; ++bj)
#pragma unroll
                    for (int n = 0; n < 2; ++n) {
                        size_t off = (size_t)row * DM + pn * 256 + bj * 128 + t.wc * 32 + n * 16 + t.fq * 4;
                        f32x4 v = xs[mm][bj][n] + acc[ai][bj][m][n] * alpha;
                        *(f32x4*)(xdst + off) = v;
                        u32x2 w; w[0] = cvt_pk(v[0], v[1]); w[1] = cvt_pk(v[2], v[3]);
                        *(u32x2*)(xb + off) = w;
                        ss += v[0] * v[0] + v[1] * v[1] + v[2] * v[2] + v[3] * v[3];
                    }
                ss += __shfl_xor(ss, 16); ss += __shfl_xor(ss, 32);
                if (t.fq == 0) red[t.wc * 256 + rl] = ss;
            }
        }
    __syncthreads();
    if (t.tid < 256) ssq[(size_t)(pm * 256 + t.tid) * 4 + pn] = red[t.tid] + red[256 + t.tid] + red[512 + t.tid] + red[768 + t.tid];
}
template <int MODE>
__device__ __forceinline__ void epi_scaled(Acc& acc, int pm, int pn, const float* ssq, const float* rq, const float* rkv, bf16_t* out, int ldo) {
    TileIdx t = tile_idx();
    float rsv[2][4];
#pragma unroll
    for (int ai = 0; ai < 2; ++ai)
#pragma unroll
        for (int m = 0; m < 4; ++m) {
            const int row = pm * 256 + ai * 128 + t.wr * 64 + m * 16 + t.fr;
            if (MODE == 1) rsv[ai][m] = (pn < 3) ? rq[row] : rkv[row];
            else rsv[ai][m] = rstd_from_ssq(ssq, row);
        }
#pragma unroll
    for (int ai = 0; ai < 2; ++ai)
#pragma unroll
        for (int m = 0; m < 4; ++m) {
            int row = pm * 256 + ai * 128 + t.wr * 64 + m * 16 + t.fr;
            const float rs = rsv[ai][m];
#pragma unroll
            for (int bj = 0; bj < 2; ++bj)
#pragma unroll
                for (int n = 0; n < 2; ++n) {
                    f32x4 v = acc[ai][bj][m][n] * rs;
                    if (MODE == 2) {
#pragma unroll
                        for (int j = 0; j < 4; ++j) v[j] = sigmoidf_(v[j]);
                    }
                    u32x2 w; w[0] = cvt_pk(v[0], v[1]); w[1] = cvt_pk(v[2], v[3]);
                    *(u32x2*)(out + (size_t)row * ldo + pn * 256 + bj * 128 + t.wc * 32 + n * 16 + t.fq * 4) = w;
                }
        }
}

__device__ __forceinline__ void tile_of(int w, int nM, int& pm, int& pn) { pm = w % nM; pn = w / nM; }

struct CJob { const float* src; int ldsrc, K, Nvalid, Ntot; bf16_t* dst; int lddst, koff; const float* gain; int perm; };
__device__ __forceinline__ CJob get_job(int j, const Ctx& a, int l) {
    unsigned char* ws = a.ws; CJob c{}; c.koff = 0; c.gain = nullptr; c.perm = 0;
    switch (j) {
    case 0: c.src = a.in(I_FFA_WIN) + (size_t)l * DM * FF2; c.ldsrc = FF2; c.K = DM; c.Nvalid = c.Ntot = FF2; c.dst = (bf16_t*)(ws + W_FFA_IN); c.lddst = DM; c.gain = a.in(I_FFA_NORM) + l * DM; c.perm = 1; break;
    case 1: c.src = a.in(I_FFA_WOUT) + (size_t)l * FF * DM; c.ldsrc = DM; c.K = FF; c.Nvalid = c.Ntot = DM; c.dst = (bf16_t*)(ws + W_FFA_OUT); c.lddst = FF; break;
    case 2: c.src = a.in(I_WIN) + (size_t)l * DM * DIN; c.ldsrc = DIN; c.K = DM; c.Nvalid = 4008; c.Ntot = PA; c.dst = (bf16_t*)(ws + W_INA); c.lddst = DM; c.gain = a.in(I_MIX_NORM) + l * DM; break;
    case 3: c.src = a.in(I_WIN) + (size_t)l * DM * DIN + 4008; c.ldsrc = DIN; c.K = DM; c.Nvalid = c.Ntot = NG; c.dst = (bf16_t*)(ws + W_GATE); c.lddst = DM; c.gain = a.in(I_MIX_NORM) + l * DM; break;
    case 4: case 5: case 6: { int n = j - 4; c.src = a.in(I_WBR) + (size_t)(l * 3 + n) * 512 * DM; c.ldsrc = DM; c.K = 512; c.Nvalid = c.Ntot = DM; c.dst = (bf16_t*)(ws + W_BR); c.lddst = BR; c.koff = n * 512; break; }
    case 7: c.src = a.in(I_WOUT) + (size_t)l * DM * DM; c.ldsrc = DM; c.K = DM; c.Nvalid = c.Ntot = DM; c.dst = (bf16_t*)(ws + W_OUT); c.lddst = DM; break;
    case 8: c.src = a.in(I_FFB_WIN) + (size_t)l * DM * FF2; c.ldsrc = FF2; c.K = DM; c.Nvalid = c.Ntot = FF2; c.dst = (bf16_t*)(ws + W_FFB_IN); c.lddst = DM; c.gain = a.in(I_FFB_NORM) + l * DM; c.perm = 1; break;
    default: c.src = a.in(I_FFB_WOUT) + (size_t)l * FF * DM; c.ldsrc = DM; c.K = FF; c.Nvalid = c.Ntot = DM; c.dst = (bf16_t*)(ws + W_FFB_OUT); c.lddst = FF; break;
    }
    return c;
}

__device__ __forceinline__ void phase_convert(const Ctx& a, int l, LAS unsigned char* lds) {
    const int tid = fresh_tid();
    LAS float* tile = (LAS float*)lds;
    int base = 0;
    for (int j = 0; j < 10; ++j) {
        CJob c = get_job(j, a, l);
        const int nkt = c.K / 64, nnt = c.Ntot / 64, ntile = nkt * nnt;
        int first = (int)((fresh_bid() + gridDim.x - (base % gridDim.x)) % gridDim.x);
        float pv[8];
#define CV_LOAD(ii) do { const int kt_ = (ii) / nnt, ntl_ = (ii) % nnt; const int n_ = ntl_ * 64 + (tid & 63); const int ncl_ = n_ < c.Nvalid ? n_ : c.Nvalid - 1; \
            const float* sp_ = c.src + (size_t)(kt_ * 64 + (tid >> 6)) * c.ldsrc + ncl_; \
            _Pragma("unroll") for (int it = 0; it < 8; ++it) pv[it] = sp_[(size_t)(it * 8) * c.ldsrc]; \
            if (c.gain) { const float* gp_ = c.gain + kt_ * 64 + (tid >> 6); _Pragma("unroll") for (int it = 0; it < 8; ++it) pv[it] *= gp_[it * 8]; } \
            if (n_ >= c.Nvalid) { _Pragma("unroll") for (int it = 0; it < 8; ++it) pv[it] = 0.f; } } while (0)
        if (first < ntile) CV_LOAD(first);
        for (int i = first; i < ntile; i += gridDim.x) {
            const int kt = i / nnt, ntl = i % nnt, k0 = kt * 64, n0 = ntl * 64;
#pragma unroll
            for (int it = 0; it < 8; ++it) tile[((tid >> 6) + it * 8) * 65 + (tid & 63)] = pv[it];
            __syncthreads();
            if (i + (int)gridDim.x < ntile) CV_LOAD(i + gridDim.x);
            {
                int nn = tid >> 3, kc = (tid & 7) * 8, n = n0 + nn, row = n;
                if (c.perm) { if (n < FF) row = (n / 128) * 256 + (n % 128); else { int jn = n - FF; row = (jn / 128) * 256 + 128 + (jn % 128); } }
                u32x4 w;
                w[0] = cvt_pk(tile[(kc + 0) * 65 + nn], tile[(kc + 1) * 65 + nn]);
                w[1] = cvt_pk(tile[(kc + 2) * 65 + nn], tile[(kc + 3) * 65 + nn]);
                w[2] = cvt_pk(tile[(kc + 4) * 65 + nn], tile[(kc + 5) * 65 + nn]);
                w[3] = cvt_pk(tile[(kc + 6) * 65 + nn], tile[(kc + 7) * 65 + nn]);
                *(u32x4*)(c.dst + (size_t)row * c.lddst + c.koff + k0 + kc) = w;
            }
            __syncthreads();
        }
        base += ntile;
    }
    {
        const float* wuq = a.in(I_WUQ) + (size_t)l * 256 * 768; const float* wukv = a.in(I_WUKV) + (size_t)l * 128 * 1024;
        const float* gq = a.in(I_CQ_NORM) + l * 256; const float* gkv = a.in(I_CKV_NORM) + l * 128;
        bf16_t* dst = (bf16_t*)(a.ws + W_MLA);
        for (int ch = fresh_bid() * NT + tid; ch < MR * 48; ch += gridDim.x * NT) {
            int n = ch % MR, kc = (ch / MR) * 8;
            float v[8];
#pragma unroll
            for (int e = 0; e < 8; ++e) {
                const int k = kc + e;
                const int kq_ = k < 256 ? k : 255, nq_ = n < 768 ? n : 767, kk_ = k >= 256 ? k - 256 : 0, nk_ = n >= 768 ? n - 768 : 0;
                const float xq = gq[kq_] * wuq[(size_t)kq_ * 768 + nq_], xk = gkv[kk_] * wukv[(size_t)kk_ * 1024 + nk_];
                v[e] = (n < 768) ? (k < 256 ? xq : 0.f) : (k >= 256 ? xk : 0.f);
            }
            u32x4 w; w[0] = cvt_pk(v[0], v[1]); w[1] = cvt_pk(v[2], v[3]); w[2] = cvt_pk(v[4], v[5]); w[3] = cvt_pk(v[6], v[7]);
            *(u32x4*)(dst + (size_t)n * 384 + kc) = w;
        }
    }
    if (l == 0) {
        float2* t64 = (float2*)(a.ws + WS_TAB64); float2* t32 = (float2*)(a.ws + WS_TAB32);
        for (int e = fresh_bid() * NT + tid; e < SEQ * 48; e += gridDim.x * NT) {
            int s = e / 48, i = e % 48;
            float invf; float2* dst;
            if (i < 32) { invf = exp2f(-(float)(2 * i) / 64.f * 13.287712379549449f); dst = t64 + s * 32 + i; }
            else { int ii = i - 32; invf = exp2f(-(float)(2 * ii) / 32.f * 13.287712379549449f); dst = t32 + s * 16 + ii; }
            float ang = (float)s * invf;
            double rev = (double)ang * 0.15915494309189535; rev -= floor(rev);
            float fr = (float)rev;
            *dst = make_float2(__builtin_amdgcn_cosf(fr), __builtin_amdgcn_sinf(fr));
        }
        const float* x = a.in(I_X); bf16_t* xb = (bf16_t*)(a.ws + WS_XB); float* ssq = (float*)(a.ws + WS_SSQ);
        for (int r2 = fresh_bid(); r2 < T / 2; r2 += gridDim.x) {
            int row = r2 * 2 + (tid >> 8), tt = tid & 255;
            f32x4 v = *(const f32x4*)(x + (size_t)row * DM + tt * 4);
            u32x2 w; w[0] = cvt_pk(v[0], v[1]); w[1] = cvt_pk(v[2], v[3]);
            *(u32x2*)(xb + (size_t)row * DM + tt * 4) = w;
            float ss = wave_sum(v[0] * v[0] + v[1] * v[1] + v[2] * v[2] + v[3] * v[3]);
            if ((tid & 63) == 0) ssq[(size_t)row * 4 + (tt >> 6)] = ss;
        }
        if (fresh_bid() == 0 && tid < 64) ((unsigned*)(a.ws + WS_CTR))[tid] = 0u;
    }
}

__device__ __forceinline__ void phase_ffn1(const Ctx& a, const bf16_t* W, LAS unsigned char* lds) {
    const bf16_t* xb = (const bf16_t*)(a.ws + WS_XB); const float* ssq = (const float*)(a.ws + WS_SSQ); bf16_t* act = (bf16_t*)(a.ws + B_ACT);
    const int nM = T / 256, ntile = nM * (FF2 / 256);
    { const int w0 = fresh_bid(); if (w0 < ntile) { int pm0, pn0; tile_of(w0, nM, pm0, pn0); gemm_stage_first(xb, DM, W, DM, pm0 * 256, pn0 * 256, lds); } }
    for (int w = fresh_bid(); w < ntile; w += gridDim.x) {
        int pm, pn; tile_of(w, nM, pm, pn);
        Acc acc; ACC_ZERO(acc);
        gemm_kloop<true>(acc, xb, DM, W, DM, pm * 256, pn * 256, DM / 64, lds);
        { const int wn = w + (int)gridDim.x; if (wn < ntile) { int pm2, pn2; tile_of(wn, nM, pm2, pn2); gemm_stage_first(xb, DM, W, DM, pm2 * 256, pn2 * 256, lds); } }
        epi_swiglu(acc, pm, pn, ssq, act);
        __syncthreads();
    }
}
__device__ __forceinline__ void phase_resid_gemm(const Ctx& a, const bf16_t* A, int K, const bf16_t* W, const float* xsrc, float alpha, LAS unsigned char* lds) {
    bf16_t* xb = (bf16_t*)(a.ws + WS_XB); float* ssq = (float*)(a.ws + WS_SSQ);
    const int nM = T / 256, ntile = nM * (DM / 256);
    for (int w = fresh_bid(); w < ntile; w += gridDim.x) {
        int pm, pn; tile_of(w, nM, pm, pn);
        Acc acc; ACC_ZERO(acc);
        gemm_kloop(acc, A, K, W, K, pm * 256, pn * 256, K / 64, lds);
        __syncthreads();
        epi_resid(acc, pm, pn, xsrc, a.out, xb, ssq, alpha, lds);
        __syncthreads();
    }
}
__device__ __forceinline__ void phase_proj(const Ctx& a, int b, LAS unsigned char* lds) {
    const bf16_t* xb = (const bf16_t*)(a.ws + WS_XB) + (size_t)b * SEQ * DM; const float* ssq = (const float*)(a.ws + WS_SSQ) + (size_t)b * SEQ * 4;
    const bf16_t* W = (const bf16_t*)(a.ws + W_INA); bf16_t* pa = (bf16_t*)(a.ws + B_PROJ);
    const int nM = SEQ / 256, ntile = nM * (PA / 256);
    { const int w0 = fresh_bid(); if (w0 < ntile) { int pm0, pn0; tile_of(w0, nM, pm0, pn0); gemm_stage_first(xb, DM, W, DM, pm0 * 256, pn0 * 256, lds); } }
    for (int w = fresh_bid(); w < ntile; w += gridDim.x) {
        int pm, pn; tile_of(w, nM, pm, pn);
        Acc acc; ACC_ZERO(acc);
        gemm_kloop<true>(acc, xb, DM, W, DM, pm * 256, pn * 256, DM / 64, lds);
        { const int wn = w + (int)gridDim.x; if (wn < ntile) { int pm2, pn2; tile_of(wn, nM, pm2, pn2); gemm_stage_first(xb, DM, W, DM, pm2 * 256, pn2 * 256, lds); } }
        epi_scaled<0>(acc, pm, pn, ssq, nullptr, nullptr, pa, PA);
        __syncthreads();
    }
}
__device__ __forceinline__ void phase_mlaup(const Ctx& a, LAS unsigned char* lds) {
    const bf16_t* pa = (const bf16_t*)(a.ws + B_PROJ); const bf16_t* W = (const bf16_t*)(a.ws + W_MLA); bf16_t* mr = (bf16_t*)(a.ws + B_MLA);
    const float* rq = (const float*)(a.ws + WS_RQ); const float* rkv = (const float*)(a.ws + WS_RKV);
    const int nM = SEQ / 256, ntile = nM * (MR / 256);
    for (int w = fresh_bid(); w < ntile; w += gridDim.x) {
        int pm, pn; tile_of(w, nM, pm, pn);
        Acc acc; ACC_ZERO(acc);
        gemm_kloop(acc, pa, PA, W, 384, pm * 256, pn * 256, 384 / 64, lds);
        epi_scaled<1>(acc, pm, pn, nullptr, rq, rkv, mr, MR);
        __syncthreads();
    }
}
__device__ __forceinline__ void phase_gates(const Ctx& a, LAS unsigned char* lds) {
    const bf16_t* xb = (const bf16_t*)(a.ws + WS_XB); const float* ssq = (const float*)(a.ws + WS_SSQ);
    const bf16_t* W = (const bf16_t*)(a.ws + W_GATE); bf16_t* g = (bf16_t*)(a.ws + B_GATES);
    const int nM = T / 256, ntile = nM * (NG / 256);
    { const int w0 = fresh_bid(); if (w0 < ntile) { int pm0, pn0; tile_of(w0, nM, pm0, pn0); gemm_stage_first(xb, DM, W, DM, pm0 * 256, pn0 * 256, lds); } }
    for (int w = fresh_bid(); w < ntile; w += gridDim.x) {
        int pm, pn; tile_of(w, nM, pm, pn);
        Acc acc; ACC_ZERO(acc);
        gemm_kloop<true>(acc, xb, DM, W, DM, pm * 256, pn * 256, DM / 64, lds);
        { const int wn = w + (int)gridDim.x; if (wn < ntile) { int pm2, pn2; tile_of(wn, nM, pm2, pn2); gemm_stage_first(xb, DM, W, DM, pm2 * 256, pn2 * 256, lds); } }
        epi_scaled<2>(acc, pm, pn, ssq, nullptr, nullptr, g, NG);
        __syncthreads();
    }
}
__device__ __forceinline__ void phase_merge(const Ctx& a, LAS unsigned char* lds) {
    const bf16_t* br = (const bf16_t*)(a.ws + B_BRANCH); const bf16_t* W = (const bf16_t*)(a.ws + W_BR);
    const bf16_t* g = (const bf16_t*)(a.ws + B_GATES); bf16_t* mg = (bf16_t*)(a.ws + B_MERGED);
    const int nM = T / 256, ntile = nM * (DM / 256);
    for (int w = fresh_bid(); w < ntile; w += gridDim.x) {
        int pm, pn; tile_of(w, nM, pm, pn);
        Acc acc; ACC_ZERO(acc);
#pragma unroll 1
        for (int seg = 0; seg < 3; ++seg) {
            gemm_kloop(acc, br + seg * 512, BR, W + seg * 512, BR, pm * 256, pn * 256, 512 / 64, lds);
            __syncthreads();
            TileIdx t = tile_idx();
#pragma unroll
            for (int ai = 0; ai < 2; ++ai)
#pragma unroll
                for (int m = 0; m < 4; ++m) {
                    int row = pm * 256 + ai * 128 + t.wr * 64 + m * 16 + t.fr;
#pragma unroll
                    for (int bj = 0; bj < 2; ++bj)
#pragma unroll
                        for (int n = 0; n < 2; ++n) {
                            int col = pn * 256 + bj * 128 + t.wc * 32 + n * 16 + t.fq * 4;
                            const bf16_t* gp = g + (size_t)row * NG + col;
                            u32x2 gc = *(const u32x2*)(gp + seg * DM);
                            float c0 = lo_bf(gc[0]), c1 = hi_bf(gc[0]), c2 = lo_bf(gc[1]), c3 = hi_bf(gc[1]);
                            if (seg < 2) {
                                u32x2 gn = *(const u32x2*)(gp + (seg + 1) * DM);
                                c0 = c0 / fmaxf(lo_bf(gn[0]), 1e-30f); c1 = c1 / fmaxf(hi_bf(gn[0]), 1e-30f);
                                c2 = c2 / fmaxf(lo_bf(gn[1]), 1e-30f); c3 = c3 / fmaxf(hi_bf(gn[1]), 1e-30f);
                                acc[ai][bj][m][n][0] *= c0; acc[ai][bj][m][n][1] *= c1; acc[ai][bj][m][n][2] *= c2; acc[ai][bj][m][n][3] *= c3;
                            } else {
                                u32x2 o; o[0] = cvt_pk(acc[ai][bj][m][n][0] * c0, acc[ai][bj][m][n][1] * c1); o[1] = cvt_pk(acc[ai][bj][m][n][2] * c2, acc[ai][bj][m][n][3] * c3);
                                *(u32x2*)(mg + (size_t)row * DM + col) = o;
                            }
                        }
                    __builtin_amdgcn_sched_barrier(0);
                }
        }
        __syncthreads();
    }
}

__device__ __forceinline__ void phase_post1(const Ctx& a, int l, LAS unsigned char* lds) {
    bf16_t* pa = (bf16_t*)(a.ws + B_PROJ); float* rq = (float*)(a.ws + WS_RQ); float* rkv = (float*)(a.ws + WS_RKV);
    const float2* t64 = (const float2*)(a.ws + WS_TAB64);
    const float* gq = a.in(I_MQN) + l * 64; const float* gk = a.in(I_MKN) + l * 64;
    const int lane = fresh_tid() & 63, wv = fresh_tid() >> 6;
    for (int tk = fresh_bid() * 8 + wv; tk < SEQ; tk += gridDim.x * 8) {
        bf16_t* pr = pa + (size_t)tk * PA;
        u32x2 cq = *(const u32x2*)(pr + C_CQ + lane * 4);
        float s1 = lo_bf(cq[0]) * lo_bf(cq[0]) + hi_bf(cq[0]) * hi_bf(cq[0]) + lo_bf(cq[1]) * lo_bf(cq[1]) + hi_bf(cq[1]) * hi_bf(cq[1]);
        unsigned ck = *(const unsigned*)(pr + C_CKV + lane * 2);
        float s2 = lo_bf(ck) * lo_bf(ck) + hi_bf(ck) * hi_bf(ck);
        s1 = wave_sum(s1); s2 = wave_sum(s2);
        if (lane == 0) { rq[tk] = rsqrtf(s1 * (1.f / 256.f) + EPS); rkv[tk] = rsqrtf(s2 * (1.f / 128.f) + EPS); }
        const int i = lane & 31;
        const float2 cs = t64[tk * 32 + i];
        bf16_t xa[8], xb2[8];
#pragma unroll
        for (int jj = 0; jj < 8; ++jj) { const bf16_t* p = pr + C_MQ + ((lane >> 5) + 2 * jj) * 64; xa[jj] = p[i]; xb2[jj] = p[i + 32]; }
#pragma unroll
        for (int jj = 0; jj < 8; ++jj) {
            int vec = (lane >> 5) + 2 * jj;
            bf16_t* p = pr + C_MQ + vec * 64;
            float x1 = bf2f(xa[jj]), x2 = bf2f(xb2[jj]);
            float ss = x1 * x1 + x2 * x2;
#pragma unroll
            for (int o = 16; o > 0; o >>= 1) ss += __shfl_xor(ss, o);
            float r = rsqrtf(ss * (1.f / 64.f) + EPS);
            const float* g = (vec < 8) ? gq : gk;
            float y1 = x1 * r * g[i], y2 = x2 * r * g[i + 32];
            float o1 = y1 * cs.x - y2 * cs.y, o2 = y2 * cs.x + y1 * cs.y;
            if (vec < 8) { o1 *= 0.125f * LOG2E; o2 *= 0.125f * LOG2E; }
            p[i] = f2bf(o1); p[i + 32] = f2bf(o2);
        }
    }
}

__device__ __forceinline__ void phase_post2(const Ctx& a, int l, LAS unsigned char* lds) {
    bf16_t* mr = (bf16_t*)(a.ws + B_MLA); const bf16_t* pa = (const bf16_t*)(a.ws + B_PROJ); bf16_t* kro = (bf16_t*)(a.ws + B_KROPE);
    const float2* t32 = (const float2*)(a.ws + WS_TAB32);
    const float* gq = a.in(I_QN) + l * 96; const float* gk = a.in(I_KN) + l * 96;
    const int lane = fresh_tid() & 63, wv = fresh_tid() >> 6, h = lane >> 3, j = lane & 7;
    const float QS = 0.10206207261596575f * LOG2E;
    for (int tk = fresh_bid() * 8 + wv; tk < SEQ; tk += gridDim.x * 8) {
        const float2 cs0 = t32[tk * 16 + 2 * j], cs1 = t32[tk * 16 + 2 * j + 1];
        const u32x4 nvk = *(const u32x4*)(mr + (size_t)tk * MR + 768 + h * 128 + j * 8);
        const unsigned avk = *(const unsigned*)(pa + (size_t)tk * PA + C_KR + 2 * j), bvk = *(const unsigned*)(pa + (size_t)tk * PA + C_KR + 16 + 2 * j);
        {
            bf16_t* q = mr + (size_t)tk * MR + h * 96;
            u32x4 nv = *(const u32x4*)(q + j * 8);
            unsigned av = *(const unsigned*)(q + 64 + 2 * j), bv = *(const unsigned*)(q + 80 + 2 * j);
            float x[8]; x[0] = lo_bf(nv[0]); x[1] = hi_bf(nv[0]); x[2] = lo_bf(nv[1]); x[3] = hi_bf(nv[1]); x[4] = lo_bf(nv[2]); x[5] = hi_bf(nv[2]); x[6] = lo_bf(nv[3]); x[7] = hi_bf(nv[3]);
            float a0 = lo_bf(av), a1 = hi_bf(av), b0 = lo_bf(bv), b1 = hi_bf(bv);
            float ss = a0 * a0 + a1 * a1 + b0 * b0 + b1 * b1;
#pragma unroll
            for (int e = 0; e < 8; ++e) ss += x[e] * x[e];
            ss += __shfl_xor(ss, 1); ss += __shfl_xor(ss, 2); ss += __shfl_xor(ss, 4);
            float r = rsqrtf(ss * (1.f / 96.f) + EPS) * QS;
#pragma unroll
            for (int e = 0; e < 8; ++e) x[e] *= r * gq[j * 8 + e];
            float ya0 = a0 * r * gq[64 + 2 * j], ya1 = a1 * r * gq[65 + 2 * j], yb0 = b0 * r * gq[80 + 2 * j], yb1 = b1 * r * gq[81 + 2 * j];
            float oa0 = ya0 * cs0.x - yb0 * cs0.y, ob0 = yb0 * cs0.x + ya0 * cs0.y;
            float oa1 = ya1 * cs1.x - yb1 * cs1.y, ob1 = yb1 * cs1.x + ya1 * cs1.y;
            u32x4 w; w[0] = cvt_pk(x[0], x[1]); w[1] = cvt_pk(x[2], x[3]); w[2] = cvt_pk(x[4], x[5]); w[3] = cvt_pk(x[6], x[7]);
            *(u32x4*)(q + j * 8) = w;
            *(unsigned*)(q + 64 + 2 * j) = cvt_pk(oa0, oa1);
            *(unsigned*)(q + 80 + 2 * j) = cvt_pk(ob0, ob1);
        }
        {
            bf16_t* k = mr + (size_t)tk * MR + 768 + h * 128;
            const bf16_t* kr = pa + (size_t)tk * PA + C_KR;
            const u32x4 nv = nvk; const unsigned av = avk, bv = bvk;
            float x[8]; x[0] = lo_bf(nv[0]); x[1] = hi_bf(nv[0]); x[2] = lo_bf(nv[1]); x[3] = hi_bf(nv[1]); x[4] = lo_bf(nv[2]); x[5] = hi_bf(nv[2]); x[6] = lo_bf(nv[3]); x[7] = hi_bf(nv[3]);
            float a0 = lo_bf(av), a1 = hi_bf(av), b0 = lo_bf(bv), b1 = hi_bf(bv);
            float ss = a0 * a0 + a1 * a1 + b0 * b0 + b1 * b1;
#pragma unroll
            for (int e = 0; e < 8; ++e) ss += x[e] * x[e];
            ss += __shfl_xor(ss, 1); ss += __shfl_xor(ss, 2); ss += __shfl_xor(ss, 4);
            float r = rsqrtf(ss * (1.f / 96.f) + EPS);
#pragma unroll
            for (int e = 0; e < 8; ++e) x[e] *= r * gk[j * 8 + e];
            float ya0 = a0 * r * gk[64 + 2 * j], ya1 = a1 * r * gk[65 + 2 * j], yb0 = b0 * r * gk[80 + 2 * j], yb1 = b1 * r * gk[81 + 2 * j];
            float oa0 = ya0 * cs0.x - yb0 * cs0.y, ob0 = yb0 * cs0.x + ya0 * cs0.y;
            float oa1 = ya1 * cs1.x - yb1 * cs1.y, ob1 = yb1 * cs1.x + ya1 * cs1.y;
            u32x4 w; w[0] = cvt_pk(x[0], x[1]); w[1] = cvt_pk(x[2], x[3]); w[2] = cvt_pk(x[4], x[5]); w[3] = cvt_pk(x[6], x[7]);
            *(u32x4*)(k + j * 8) = w;
            bf16_t* ko = kro + ((size_t)tk * 8 + h) * 32;
            *(unsigned*)(ko + 2 * j) = cvt_pk(oa0, oa1);
            *(unsigned*)(ko + 16 + 2 * j) = cvt_pk(ob0, ob1);
        }
    }
}

__device__ __forceinline__ void kmean_items(const Ctx& a, LAS unsigned char* lds) {
    const bf16_t* pa = (const bf16_t*)(a.ws + B_PROJ);
    float* kmean = (float*)(a.ws + WS_KMEAN);
    LAS float* part = (LAS float*)lds;
    for (int it = fresh_bid(); it < 256; it += gridDim.x) {
        int hh = it >> 5, n = it & 31, d = fresh_tid() & 63, tg = fresh_tid() >> 6;
        float s = 0.f;
        for (int i = 0; i < 32; ++i) s += bf2f(pa[(size_t)(n * 256 + tg * 32 + i) * PA + C_MK + hh * 64 + d]);
        part[tg * 64 + d] = s;
        __syncthreads();
        if (fresh_tid() < 64) {
            float tsum = 0.f;
#pragma unroll
            for (int g2 = 0; g2 < 8; ++g2) tsum += part[g2 * 64 + d];
            kmean[(size_t)it * 64 + d] = tsum * (1.f / 256.f);
        }
        __syncthreads();
    }
}

__device__ __forceinline__ void moba_gate_item(const Ctx& a, int tb, LAS unsigned char* lds) {
    const bf16_t* pa = (const bf16_t*)(a.ws + B_PROJ); const float* kmean = (const float*)(a.ws + WS_KMEAN); unsigned* mask = (unsigned*)(a.ws + WS_MASK);
    const int tid = fresh_tid();
    const int tok = tid & 63, h = __builtin_amdgcn_readfirstlane(tid >> 6), tk = tb * 64 + tok, qb = tk >> 8;
    LAS float* kml = (LAS float*)lds;
    for (int e = tid; e < 8 * qb * 16; e += NT) { const int hh = e / (qb * 16), r = e % (qb * 16); *(LAS f32x4*)(kml + hh * 2048 + r * 4) = *(const f32x4*)(kmean + (size_t)hh * 2048 + r * 4); }
    float q[64];
    const bf16_t* qp = pa + (size_t)tk * PA + C_MQ + h * 64;
#pragma unroll
    for (int c = 0; c < 8; ++c) {
        u32x4 v = *(const u32x4*)(qp + c * 8);
#pragma unroll
        for (int e = 0; e < 4; ++e) { q[c * 8 + 2 * e] = lo_bf(v[e]); q[c * 8 + 2 * e + 1] = hi_bf(v[e]); }
    }
    __syncthreads();
    float v1 = -3e38f, v2 = -3e38f, v3 = -3e38f; int i1 = -1, i2 = -1, i3 = -1;
    for (int n = 0; n < qb; ++n) {
        const LAS float* km = kml + h * 2048 + n * 64;
        float s = 0.f;
#pragma unroll
        for (int d4 = 0; d4 < 16; ++d4) { f32x4 kv = *(const LAS f32x4*)(km + d4 * 4); s += q[d4 * 4] * kv[0] + q[d4 * 4 + 1] * kv[1] + q[d4 * 4 + 2] * kv[2] + q[d4 * 4 + 3] * kv[3]; }
        if (s > v1) { v3 = v2; i3 = i2; v2 = v1; i2 = i1; v1 = s; i1 = n; }
        else if (s > v2) { v3 = v2; i3 = i2; v2 = s; i2 = n; }
        else if (s > v3) { v3 = s; i3 = n; }
    }
    unsigned m = 1u << qb;
    if (i1 >= 0) m |= 1u << i1;
    if (i2 >= 0) m |= 1u << i2;
    if (i3 >= 0) m |= 1u << i3;
    mask[(size_t)h * SEQ + tk] = m;
    __syncthreads();
}

constexpr int GI_QB = 0, GI_KB = 17408, GI_VF = 34816, GI_AM = 34816 + 65536, GI_SM = GI_AM + 17408;
__device__ __forceinline__ void gdn_intra_item(const Ctx& a, int l, int h, int c, LAS unsigned char* lds) {
    const bf16_t* pa = (const bf16_t*)(a.ws + B_PROJ);
    LAS bf16_t* qb = (LAS bf16_t*)(lds + GI_QB); LAS bf16_t* kb = (LAS bf16_t*)(lds + GI_KB);
    LAS float* vf = (LAS float*)(lds + GI_VF);
    LAS float* Am = (LAS float*)(lds + GI_AM);
    LAS float* sm = (LAS float*)(lds + GI_SM);
    LAS float* gc = sm; LAS float* be = sm + 64; LAS float* sq = sm + 128; LAS float* sk = sm + 256; LAS float* rqv = sm + 384; LAS float* rkv = sm + 448; LAS float* eg = sm + 512;
    const int tid = fresh_tid(), lane = tid & 63, wv = tid >> 6;
    const int t0 = c * 64;
    if (wv == 0) {
        const bf16_t* pr = pa + (size_t)(t0 + lane) * PA;
        float al = bf2f(pr[C_GA + h]) + a.in(I_DTB)[l * 4 + h];
        float sp = fmaxf(al, 0.f) + __logf(1.f + __expf(-fabsf(al)));
        float g = -__expf(a.in(I_ALOG)[l * 4 + h]) * sp;
        float bt = sigmoidf_(bf2f(pr[C_GB + h]));
#pragma unroll
        for (int o = 1; o < 64; o <<= 1) { float u = __shfl_up(g, o); if (lane >= o) g += u; }
        gc[lane] = g; be[lane] = bt; eg[lane] = __expf(g);
    }
    {
        const int d = tid & 127, rg = tid >> 7;
        const float* cw = a.in(I_CONV) + (size_t)l * 4 * 1536;
        const int ts = t0 + rg * 16;
        bf16_t xr[3][19];
#pragma unroll
        for (int part = 0; part < 3; ++part) {
            const bf16_t* src = pa + C_GQ + part * 512 + h * 128 + d;
#pragma unroll
            for (int i = 0; i < 19; ++i) { const int tt = ts - 3 + i; xr[part][i] = src[(size_t)(tt < 0 ? 0 : tt) * PA]; }
        }
        float wq[3][4];
#pragma unroll
        for (int part = 0; part < 3; ++part)
#pragma unroll
            for (int j = 0; j < 4; ++j) wq[part][j] = cw[j * 1536 + part * 512 + h * 128 + d];
#pragma unroll
        for (int part = 0; part < 3; ++part) {
#pragma unroll
            for (int i = 0; i < 16; ++i) {
                float x0 = (ts - 3 + i >= 0) ? bf2f(xr[part][i]) : 0.f, x1 = (ts - 2 + i >= 0) ? bf2f(xr[part][i + 1]) : 0.f, x2 = (ts - 1 + i >= 0) ? bf2f(xr[part][i + 2]) : 0.f;
                float y = wq[part][0] * x0 + wq[part][1] * x1 + wq[part][2] * x2 + wq[part][3] * bf2f(xr[part][i + 3]);
                y = siluf_(y);
                const int r = rg * 16 + i;
                if (part == 2) vf[r * 256 + d] = y;
                else if (part == 0) qb[r * 136 + d] = f2bf(y);
                else kb[r * 136 + d] = f2bf(y);
            }
        }
    }
    __syncthreads();
    {
        const int row = tid >> 3, part = tid & 7;
        float s1 = 0.f, s2 = 0.f;
#pragma unroll
        for (int c = 0; c < 2; ++c) {
            u32x4 qv = *(const LAS u32x4*)(qb + row * 136 + part * 16 + c * 8), kv = *(const LAS u32x4*)(kb + row * 136 + part * 16 + c * 8);
#pragma unroll
            for (int e = 0; e < 4; ++e) { float a0 = lo_bf(qv[e]), a1 = hi_bf(qv[e]), b0 = lo_bf(kv[e]), b1 = hi_bf(kv[e]); s1 += a0 * a0 + a1 * a1; s2 += b0 * b0 + b1 * b1; }
        }
        s1 += __shfl_xor(s1, 1); s1 += __shfl_xor(s1, 2); s1 += __shfl_xor(s1, 4);
        s2 += __shfl_xor(s2, 1); s2 += __shfl_xor(s2, 2); s2 += __shfl_xor(s2, 4);
        if (part == 0) { rqv[row] = rsqrtf(s1 + EPS) * 0.08838834764831845f; rkv[row] = rsqrtf(s2 + EPS); }
    }
    __syncthreads();
    {
        const int type = wv >> 2, blk = wv & 3, bi = blk >> 1, bj = blk & 1, l32 = lane & 31, hb = lane >> 5;
        LAS bf16_t* X = type ? qb : kb;
        f32x16 acc;
#pragma unroll
        for (int r = 0; r < 16; ++r) acc[r] = 0.f;
#pragma unroll
        for (int kk = 0; kk < 8; ++kk) {
            bf16x8 av = *(const LAS bf16x8*)(X + (bi * 32 + l32) * 136 + kk * 16 + hb * 8);
            bf16x8 bv = *(const LAS bf16x8*)(kb + (bj * 32 + l32) * 136 + kk * 16 + hb * 8);
            acc = __builtin_amdgcn_mfma_f32_32x32x16_bf16(av, bv, acc, 0, 0, 0);
        }
        const int jcol = bj * 32 + l32;
        const float gj = gc[jcol], rkj = rkv[jcol];
        bf16_t* qkg = (bf16_t*)(a.ws + B_GQK) + ((size_t)(h * 128 + c) * 64) * 64;
#pragma unroll
        for (int r = 0; r < 16; ++r) {
            int i = bi * 32 + (r >> 2) * 8 + hb * 4 + (r & 3);
            float dec = __expf(fminf(gc[i] - gj, 0.f));
            if (type == 0) { float v = (jcol < i) ? acc[r] * rkv[i] * rkj * be[i] * dec : 0.f; Am[i * 68 + jcol] = v; }
            else { float v = (jcol <= i) ? acc[r] * rqv[i] * rkj * dec : 0.f; qkg[(size_t)i * 64 + jcol] = f2bf(v); }
        }
    }
    __syncthreads();
    if (tid < 256) {
        const int cc = tid, d = cc & 127;
        LAS float* xc = vf + cc;
        bf16_t* dst = (bf16_t*)(a.ws + B_GW) + (size_t)t0 * 512 + h * 128 + d;
        bf16_t* dstu = (bf16_t*)(a.ws + B_GU) + ((size_t)((h * 128 + c) * 4 + (d >> 5)) * 2) * 1024 + (d & 31) * 16;
#pragma unroll 1
        for (int bs = 0; bs < 64; bs += 16) {
            float acc[16];
            if (cc < 128) {
#pragma unroll
                for (int r = 0; r < 16; ++r) { const int i = bs + r; acc[r] = xc[i * 256] * be[i]; }
            } else {
#pragma unroll
                for (int r = 0; r < 16; ++r) { const int i = bs + r; acc[r] = bf2f(kb[i * 136 + d]) * rkv[i] * be[i] * eg[i]; }
            }
#pragma unroll 1
            for (int j = 0; j < bs; j += 4) {
                const float x0 = xc[(j + 0) * 256], x1 = xc[(j + 1) * 256], x2 = xc[(j + 2) * 256], x3 = xc[(j + 3) * 256];
#pragma unroll
                for (int r = 0; r < 16; ++r) {
                    f32x4 av = *(const LAS f32x4*)(Am + (bs + r) * 68 + j);
                    acc[r] -= av[0] * x0 + av[1] * x1 + av[2] * x2 + av[3] * x3;
                }
            }
#pragma unroll
            for (int r = 0; r < 16; ++r) {
#pragma unroll
                for (int c4 = 0; c4 < (r + 3) / 4; ++c4) {
                    f32x4 av = *(const LAS f32x4*)(Am + (bs + r) * 68 + bs + c4 * 4);
#pragma unroll
                    for (int e = 0; e < 4; ++e) if (c4 * 4 + e < r) acc[r] -= av[e] * acc[c4 * 4 + e];
                }
                const int i = bs + r;
                xc[i * 256] = acc[r];
                { const int i32 = i & 31; const int offu = (i >> 5) * 1024 + ((i32 >> 2) & 1) * 512 + (i32 >> 3) * 4 + (i & 3);
                  bf16_t* ob = (cc < 128) ? dstu : dst; ob[(cc < 128) ? offu : i * 512] = f2bf(acc[r]); }
            }
        }
    } else {
        const int u = tid - 256, d = u & 127, hf = u >> 7;
        bf16_t* qd = (bf16_t*)(a.ws + B_GQD) + (size_t)t0 * 512 + h * 128 + d;
        bf16_t* kt = (bf16_t*)(a.ws + B_GKT) + ((size_t)(h * 128 + c) * 128 + d) * 64 + hf * 32;
        const float gl = gc[63];
#pragma unroll
        for (int i4 = 0; i4 < 4; ++i4) {
            float kv[8];
#pragma unroll
            for (int e = 0; e < 8; ++e) {
                int i = hf * 32 + i4 * 8 + e;
                qd[(size_t)i * 512] = f2bf(bf2f(qb[i * 136 + d]) * rqv[i] * eg[i]);
                kv[e] = bf2f(kb[i * 136 + d]) * rkv[i] * __expf(gl - gc[i]);
            }
            u32x4 w; w[0] = cvt_pk(kv[0], kv[1]); w[1] = cvt_pk(kv[2], kv[3]); w[2] = cvt_pk(kv[4], kv[5]); w[3] = cvt_pk(kv[6], kv[7]);
            *(u32x4*)(kt + i4 * 8) = w;
        }
        if (u == 0) ((float*)(a.ws + WS_GLAST))[h * 128 + c] = gl;
    }
    __syncthreads();
}

__device__ __forceinline__ void phase_prep(const Ctx& a, int l, LAS unsigned char* lds) {
    for (int it = fresh_bid(); it < 512 + 128; it += gridDim.x) {
        if (it < 512) gdn_intra_item(a, l, it & 3, it >> 2, lds);
        else moba_gate_item(a, it - 512, lds);
    }
}

constexpr int GS_W = 0, GS_Q = 16896, GS_K = 33792, GS_QK = 51200, GS_BUF = 59904, GS_O = 2 * GS_BUF;
__device__ __forceinline__ bf16x8 lds_a2(const LAS bf16_t* p) {
    u32x2 lo = *(const LAS u32x2*)p, hi = *(const LAS u32x2*)(p + 8);
    u32x4 v; v[0] = lo[0]; v[1] = lo[1]; v[2] = hi[0]; v[3] = hi[1];
    return __builtin_bit_cast(bf16x8, v);
}
__device__ __forceinline__ bf16x8 pack8(const f32x16& v, int c) {
    u32x4 w; w[0] = cvt_pk(v[c * 8 + 0], v[c * 8 + 1]); w[1] = cvt_pk(v[c * 8 + 2], v[c * 8 + 3]); w[2] = cvt_pk(v[c * 8 + 4], v[c * 8 + 5]); w[3] = cvt_pk(v[c * 8 + 6], v[c * 8 + 7]);
    return __builtin_bit_cast(bf16x8, w);
}
__device__ __forceinline__ void gdn_scan_item(const Ctx& a, int l, int b, int h, int half, LAS unsigned char* lds, int variant) {
    const int tid = fresh_tid(), lane = tid & 63, wv = tid >> 6, l32 = lane & 31, hb = lane >> 5;
    const bf16_t* gu = (const bf16_t*)(a.ws + B_GU); const bf16_t* gw = (const bf16_t*)(a.ws + B_GW); const bf16_t* gqd = (const bf16_t*)(a.ws + B_GQD);
    const bf16_t* gkt = (const bf16_t*)(a.ws + B_GKT); const bf16_t* gqk = (const bf16_t*)(a.ws + B_GQK); const float* glast = (const float*)(a.ws + WS_GLAST);
    const bf16_t* pa = (const bf16_t*)(a.ws + B_PROJ); bf16_t* br = (bf16_t*)(a.ws + B_BRANCH);
    const bool loader = wv >= 4;
    const int u = tid - 256;
    u32x4 pfA[14], pfB[14];
    const unsigned offWQ = (unsigned)(((u >> 4) * 512 + (u & 15) * 8) * 2), offKT = (unsigned)(((u >> 3) * 64 + (u & 7) * 8) * 2);
#define GS_LOAD(n, pf) do { const char* w_ = (const char*)(gw + (size_t)((n) * 64) * 512 + h * 128); const char* q_b = (const char*)(gqd + (size_t)((n) * 64) * 512 + h * 128); \
    const char* k_ = (const char*)(gkt + (size_t)(h * 128 + (n)) * 128 * 64); const char* qk_ = (const char*)(gqk + (size_t)(h * 128 + (n)) * 64 * 64); \
    _Pragma("unroll") for (int q_ = 0; q_ < 4; ++q_) pf[q_] = *(const u32x4*)(w_ + q_ * 16 * 512 * 2 + offWQ); \
    _Pragma("unroll") for (int q_ = 0; q_ < 4; ++q_) pf[4 + q_] = *(const u32x4*)(q_b + q_ * 16 * 512 * 2 + offWQ); \
    _Pragma("unroll") for (int q_ = 0; q_ < 4; ++q_) pf[8 + q_] = *(const u32x4*)(k_ + q_ * 32 * 64 * 2 + offKT); \
    _Pragma("unroll") for (int q_ = 0; q_ < 2; ++q_) pf[12 + q_] = *(const u32x4*)(qk_ + q_ * 32 * 64 * 2 + offKT); } while (0)
#define GS_ST8(p, v) do { LAS u32x2* p_ = (LAS u32x2*)(p); u32x2 a_; a_[0] = (v)[0]; a_[1] = (v)[1]; u32x2 b_; b_[0] = (v)[2]; b_[1] = (v)[3]; p_[0] = a_; p_[1] = b_; } while (0)
#define GS_STORE(bufi, pf) do { LAS unsigned char* B_ = lds + (bufi) * GS_BUF; \
    _Pragma("unroll") for (int q_ = 0; q_ < 4; ++q_) { int ch = u + q_ * 256; GS_ST8(B_ + GS_W + (ch >> 4) * 264 + (ch & 15) * 16, pf[q_]); } \
    _Pragma("unroll") for (int q_ = 0; q_ < 4; ++q_) { int ch = u + q_ * 256; GS_ST8(B_ + GS_Q + (ch >> 4) * 264 + (ch & 15) * 16, pf[4 + q_]); } \
    _Pragma("unroll") for (int q_ = 0; q_ < 4; ++q_) { int ch = u + q_ * 256; GS_ST8(B_ + GS_K + (ch >> 3) * 136 + (ch & 7) * 16, pf[8 + q_]); } \
    _Pragma("unroll") for (int q_ = 0; q_ < 2; ++q_) { int ch = u + q_ * 256; GS_ST8(B_ + GS_QK + (ch >> 3) * 136 + (ch & 7) * 16, pf[12 + q_]); } } while (0)
#define GS_BAR() asm volatile("s_waitcnt lgkmcnt(0)\n\ts_barrier" ::: "memory")
    f32x16 S[4];
#pragma unroll
    for (int kb = 0; kb < 4; ++kb)
#pragma unroll
        for (int r = 0; r < 16; ++r) S[kb][r] = 0.f;
    const int dv0 = half * 32;
    u32x4 U[2][2]; float gl_next = 0.f;
#define GS_LOADU(n) do { const bf16_t* up_ = gu + ((size_t)((h * 128 + (n)) * 4 + half) * 2) * 1024 + lane * 16; \
    _Pragma("unroll") for (int tb_ = 0; tb_ < 2; ++tb_) { U[tb_][0] = *(const u32x4*)(up_ + tb_ * 1024); U[tb_][1] = *(const u32x4*)(up_ + tb_ * 1024 + 8); } \
    gl_next = __expf(glast[h * 128 + (n)]); } while (0)

    if (loader) { GS_LOAD(0, pfA); GS_STORE(0, pfA); GS_LOAD(1, pfB); } else if (wv < 1) { GS_LOADU(0); }
    __syncthreads();
    if (loader) {
        for (int n = 0; n < 128; n += 2) {
            const int c2 = (n + 2 < 128) ? n + 2 : 127, c3 = (n + 3 < 128) ? n + 3 : 127;
            if (variant != 1) { GS_LOAD(c2, pfA); GS_STORE(1, pfB); }
            GS_BAR();
            if (variant != 1) { GS_LOAD(c3, pfB); GS_STORE(0, pfA); }
            GS_BAR();
        }
    } else if (wv >= 1) {
        for (int n = 0; n < 128; ++n) GS_BAR();
    } else {
        __builtin_amdgcn_s_setprio(3);
        for (int n = 0; n < 128; ++n) {
            const int bufi = n & 1;
            if (variant == 2) { GS_BAR(); continue; }
            LAS unsigned char* Bf = lds + bufi * GS_BUF;
            const LAS bf16_t* Wb = (const LAS bf16_t*)(Bf + GS_W); const LAS bf16_t* Qb = (const LAS bf16_t*)(Bf + GS_Q);
            const LAS bf16_t* Kt = (const LAS bf16_t*)(Bf + GS_K); const LAS bf16_t* QKb = (const LAS bf16_t*)(Bf + GS_QK);
            f32x16 vn[2], o[2];
            const float gl = gl_next;
#pragma unroll
            for (int tb = 0; tb < 2; ++tb)
#pragma unroll
                for (int r = 0; r < 16; ++r) { vn[tb][r] = 0.f; o[tb][r] = 0.f; }
            bf16x8 aop[16];
#pragma unroll
            for (int kb = 0; kb < 4; ++kb) {
#pragma unroll
                for (int c = 0; c < 2; ++c)
#pragma unroll
                    for (int tb = 0; tb < 2; ++tb) {
                        aop[c * 2 + tb] = lds_a2(Wb + (tb * 32 + l32) * 132 + kb * 32 + c * 16 + hb * 4);
                        aop[4 + c * 2 + tb] = lds_a2(Qb + (tb * 32 + l32) * 132 + kb * 32 + c * 16 + hb * 4);
                    }
                __builtin_amdgcn_sched_barrier(0);
#pragma unroll
                for (int c = 0; c < 2; ++c) {
                    bf16x8 sb = pack8(S[kb], c);
#pragma unroll
                    for (int tb = 0; tb < 2; ++tb) {
                        vn[tb] = __builtin_amdgcn_mfma_f32_32x32x16_bf16(aop[c * 2 + tb], sb, vn[tb], 0, 0, 0);
                        o[tb] = __builtin_amdgcn_mfma_f32_32x32x16_bf16(aop[4 + c * 2 + tb], sb, o[tb], 0, 0, 0);
                    }
                }
                __builtin_amdgcn_sched_barrier(0);
            }
            bf16x8 vb[2][2];
#pragma unroll
            for (int tb = 0; tb < 2; ++tb) {
#pragma unroll
                for (int r = 0; r < 16; ++r) { unsigned uw = U[tb][r >> 3][(r >> 1) & 3]; vn[tb][r] = ((r & 1) ? hi_bf(uw) : lo_bf(uw)) - vn[tb][r]; }
                vb[tb][0] = pack8(vn[tb], 0); vb[tb][1] = pack8(vn[tb], 1);
            }
            __builtin_amdgcn_sched_barrier(0);
            { const int n1_ = (n + 1 < 128) ? n + 1 : 127; GS_LOADU(n1_); }
            bf16x8 qop[8];
#pragma unroll
            for (int kb = 0; kb < 4; ++kb)
#pragma unroll
                for (int tb2 = 0; tb2 < 2; ++tb2)
#pragma unroll
                    for (int c = 0; c < 2; ++c) aop[(kb * 2 + tb2) * 2 + c] = lds_a2(Kt + (kb * 32 + l32) * 68 + tb2 * 32 + c * 16 + hb * 4);
#pragma unroll
            for (int kb = 0; kb < 4; ++kb)
#pragma unroll
                for (int r = 0; r < 16; ++r) S[kb][r] *= gl;
            __builtin_amdgcn_sched_barrier(0);
#pragma unroll
            for (int tb2 = 0; tb2 < 2; ++tb2)
#pragma unroll
                for (int c = 0; c < 2; ++c)
#pragma unroll
                    for (int kb = 0; kb < 4; ++kb)
                        S[kb] = __builtin_amdgcn_mfma_f32_32x32x16_bf16(aop[(kb * 2 + tb2) * 2 + c], vb[tb2][c], S[kb], 0, 0, 0);
            __builtin_amdgcn_sched_barrier(0);
#pragma unroll
            for (int tb2 = 0; tb2 < 2; ++tb2)
#pragma unroll
                for (int c = 0; c < 2; ++c)
#pragma unroll
                    for (int tb = 0; tb < 2; ++tb) qop[(tb2 * 2 + c) * 2 + tb] = lds_a2(QKb + (tb * 32 + l32) * 68 + tb2 * 32 + c * 16 + hb * 4);
            __builtin_amdgcn_sched_barrier(0);
#pragma unroll
            for (int tb2 = 0; tb2 < 2; ++tb2)
#pragma unroll
                for (int c = 0; c < 2; ++c)
#pragma unroll
                    for (int tb = 0; tb < 2; ++tb) o[tb] = __builtin_amdgcn_mfma_f32_32x32x16_bf16(qop[(tb2 * 2 + c) * 2 + tb], vb[tb2][c], o[tb], 0, 0, 0);
            __builtin_amdgcn_sched_barrier(0);
            {
                bf16_t* op = br + ((size_t)b * SEQ + n * 64) * BR + 512 + h * 128 + dv0 + l32;
#pragma unroll
                for (int tb = 0; tb < 2; ++tb)
#pragma unroll
                    for (int r = 0; r < 16; ++r) op[(size_t)(tb * 32 + (r >> 2) * 8 + hb * 4 + (r & 3)) * BR] = f2bf(o[tb][r]);
            }
            GS_BAR();
        }
        __builtin_amdgcn_s_setprio(0);
    }
    __syncthreads();
}

template <int TYPE>
__device__ __forceinline__ void attn_item(const Ctx& a, int b, int h, int qt, LAS unsigned char* lds) {
    constexpr int DK = TYPE == 0 ? 96 : 64, KLD = DK + 8, KBYTES = 128 * KLD * 2, VLD = 132, VBYTES = 64 * VLD * 2, BUF = KBYTES + VBYTES, NKK = DK / 16;
    constexpr int NKC = TYPE == 0 ? 3 : 2;
    const int tid = fresh_tid(), lane = tid & 63, wv = tid >> 6, l32 = lane & 31, hb = lane >> 5;
    const bf16_t* mr = (const bf16_t*)(a.ws + B_MLA); const bf16_t* pa = (const bf16_t*)(a.ws + B_PROJ); const bf16_t* kro = (const bf16_t*)(a.ws + B_KROPE);
    bf16_t* br = (bf16_t*)(a.ws + B_BRANCH);
    const int qrow = qt * 256 + wv * 32 + l32;
    bf16x8 Q[NKK];
    {
        const bf16_t* qp = TYPE == 0 ? mr + (size_t)qrow * MR + h * 96 : pa + (size_t)qrow * PA + C_MQ + h * 64;
#pragma unroll
        for (int kk = 0; kk < NKK; ++kk) Q[kk] = *(const bf16x8*)(qp + kk * 16 + hb * 8);
    }
    unsigned qmask = 0xffffffffu;
    if (TYPE == 1) qmask = ((const unsigned*)(a.ws + WS_MASK))[(size_t)h * SEQ + qrow];
    f32x16 oacc[2];
#pragma unroll
    for (int db = 0; db < 2; ++db)
#pragma unroll
        for (int r = 0; r < 16; ++r) oacc[db][r] = 0.f;
    float mrun = 0.f, lrun = 0.f;
    const int npair = (qt + 1) * 2;
    u32x4 kreg[NKC], vreg[2];
#define AT_LOAD(kp) do { const int k0_ = (kp) * 128; \
    _Pragma("unroll") for (int j_ = 0; j_ < NKC; ++j_) { const int ch = tid + j_ * 512; \
        if (TYPE == 0) { const int row = ch / 12, part = ch % 12; \
            const bf16_t* p_ = part < 8 ? mr + (size_t)(k0_ + row) * MR + 768 + h * 128 + part * 8 : kro + ((size_t)(k0_ + row) * 8 + h) * 32 + (part - 8) * 8; kreg[j_] = *(const u32x4*)p_; } \
        else kreg[j_] = *(const u32x4*)(pa + (size_t)(k0_ + (ch >> 3)) * PA + C_MK + h * 64 + (ch & 7) * 8); } \
    _Pragma("unroll") for (int j_ = 0; j_ < 2; ++j_) { const int ch = tid + j_ * 512, vk = ch >> 3, vc = ch & 7; \
        vreg[j_] = TYPE == 0 ? *(const u32x4*)(mr + (size_t)(k0_ + vk) * MR + 768 + h * 128 + 64 + vc * 8) : *(const u32x4*)(pa + (size_t)(k0_ + vk) * PA + C_MV + h * 64 + vc * 8); } } while (0)
#define AT_STORE(bufi) do { LAS unsigned char* B_ = lds + (bufi) * BUF; \
    _Pragma("unroll") for (int j_ = 0; j_ < NKC; ++j_) { const int ch = tid + j_ * 512; \
        if (TYPE == 0) { const int row = ch / 12, part = ch % 12; *(LAS u32x4*)(B_ + row * (KLD * 2) + part * 16) = kreg[j_]; } \
        else *(LAS u32x4*)(B_ + (ch >> 3) * (KLD * 2) + (ch & 7) * 16) = kreg[j_]; } \
    LAS bf16_t* VT_ = (LAS bf16_t*)(B_ + KBYTES); \
    _Pragma("unroll") for (int j_ = 0; j_ < 2; ++j_) { const int ch = tid + j_ * 512, vk = ch >> 3, vc = ch & 7; \
        _Pragma("unroll") for (int e_ = 0; e_ < 4; ++e_) { VT_[(vc * 8 + 2 * e_) * VLD + vk] = (bf16_t)(vreg[j_][e_] & 0xffffu); VT_[(vc * 8 + 2 * e_ + 1) * VLD + vk] = (bf16_t)(vreg[j_][e_] >> 16); } } } while (0)

    AT_LOAD(0); AT_STORE(0);
    __syncthreads();
    for (int kp = 0; kp < npair; ++kp) {
        const int bufi = kp & 1;
        if (kp + 1 < npair) AT_LOAD(kp + 1);
        LAS unsigned char* Bf = lds + bufi * BUF;
        const LAS bf16_t* Kt = (const LAS bf16_t*)Bf; const LAS bf16_t* VT = (const LAS bf16_t*)(Bf + KBYTES);
        f32x16 s[2][2];
        bool act[2];
        const float mref = mrun;
#pragma unroll
        for (int sub = 0; sub < 2; ++sub) {
            const int kloc = kp * 2 + sub - qt * 4;
            act[sub] = (kloc < 0) || (kloc * 64 <= wv * 32 + 31);
            if (TYPE == 1 && kloc < 0) act[sub] = __builtin_amdgcn_ballot_w64((qmask >> ((kp * 2 + sub) >> 2)) & 1u) != 0ull;
#pragma unroll
            for (int kb = 0; kb < 2; ++kb)
#pragma unroll
                for (int r = 0; r < 16; ++r) s[sub][kb][r] = -mref;
        }
#pragma unroll
        for (int kk = 0; kk < NKK; ++kk)
#pragma unroll
            for (int sub = 0; sub < 2; ++sub)
                if (act[sub]) {
#pragma unroll
                    for (int kb = 0; kb < 2; ++kb) {
                        bf16x8 ka = *(const LAS bf16x8*)(Kt + (sub * 64 + kb * 32 + l32) * KLD + kk * 16 + hb * 8);
                        s[sub][kb] = __builtin_amdgcn_mfma_f32_32x32x16_bf16(ka, Q[kk], s[sub][kb], 0, 0, 0);
                    }
                }
#pragma unroll
        for (int sub = 0; sub < 2; ++sub) {
            if (!act[sub]) continue;
            const int kt = kp * 2 + sub, kloc = kt - qt * 4;
            if (kloc >= 0) {
#pragma unroll
                for (int kb = 0; kb < 2; ++kb)
#pragma unroll
                    for (int r = 0; r < 16; ++r) { int kabs = kt * 64 + kb * 32 + (r >> 2) * 8 + hb * 4 + (r & 3); if (kabs > qrow) s[sub][kb][r] = -1e30f; }
            } else if (TYPE == 1) {
                if (!((qmask >> (kt >> 2)) & 1u)) {
#pragma unroll
                    for (int kb = 0; kb < 2; ++kb)
#pragma unroll
                        for (int r = 0; r < 16; ++r) s[sub][kb][r] = -1e30f;
                }
            }
            float mx = -1e30f;
#pragma unroll
            for (int kb = 0; kb < 2; ++kb)
#pragma unroll
                for (int r = 0; r < 16; ++r) mx = fmaxf(mx, s[sub][kb][r]);
            mx = fmaxf(mx, __shfl_xor(mx, 32));
            const float delta = mrun - mref;
            const bool bump = (mx - delta) > 8.f;
            const bool rare = __builtin_amdgcn_ballot_w64(bump || delta != 0.f) != 0ull;
            float fpost = 1.f;
            if (rare) {
                const float mnew = bump ? mref + mx : mrun;
                const float pre = __builtin_amdgcn_exp2f(delta);
                fpost = __builtin_amdgcn_exp2f(mref - mnew);
                mrun = mnew;
                lrun *= pre;
#pragma unroll
                for (int db = 0; db < 2; ++db)
#pragma unroll
                    for (int r = 0; r < 16; ++r) oacc[db][r] *= pre;
            }
            float ps = 0.f;
#pragma unroll
            for (int kb = 0; kb < 2; ++kb)
#pragma unroll
                for (int r = 0; r < 16; ++r) { float p = __builtin_amdgcn_exp2f(s[sub][kb][r]); s[sub][kb][r] = p; ps += p; }
            lrun += ps;
#pragma unroll
            for (int kb = 0; kb < 2; ++kb)
#pragma unroll
                for (int c = 0; c < 2; ++c) {
                    bf16x8 pb = pack8(s[sub][kb], c);
#pragma unroll
                    for (int db = 0; db < 2; ++db)
                        oacc[db] = __builtin_amdgcn_mfma_f32_32x32x16_bf16(lds_a2(VT + (db * 32 + l32) * VLD + sub * 64 + kb * 32 + c * 16 + hb * 4), pb, oacc[db], 0, 0, 0);
                }
            if (rare) {
                lrun *= fpost;
#pragma unroll
                for (int db = 0; db < 2; ++db)
#pragma unroll
                    for (int r = 0; r < 16; ++r) oacc[db][r] *= fpost;
            }
        }
        if (kp + 1 < npair) AT_STORE(bufi ^ 1);
        __syncthreads();
    }
    lrun += __shfl_xor(lrun, 32);
    const float inv = 1.f / lrun;
    bf16_t* op = br + ((size_t)b * SEQ + qrow) * BR + (TYPE == 0 ? 0 : 1024) + h * 64;
#pragma unroll
    for (int db = 0; db < 2; ++db)
#pragma unroll
        for (int g = 0; g < 4; ++g) {
            u32x2 w; w[0] = cvt_pk(oacc[db][g * 4 + 0] * inv, oacc[db][g * 4 + 1] * inv); w[1] = cvt_pk(oacc[db][g * 4 + 2] * inv, oacc[db][g * 4 + 3] * inv);
            *(u32x2*)(op + db * 32 + g * 8 + hb * 4) = w;
        }
}

__device__ __forceinline__ void phase_mix(const Ctx& a, int l, int b, LAS unsigned char* lds, int rep) {
    unsigned* ctr = (unsigned*)(a.ws + WS_CTR) + ((l * 2 + b) * 2 + rep);
    const bool do_scan = (rep == 0) || REP_MODE != 2, do_attn = (rep == 0) || REP_MODE != 1;
    LAS int* sitem = (LAS int*)(lds + LDS_BYTES - 16);
    if (do_scan && fresh_bid() < 16) gdn_scan_item(a, l, b, fresh_bid() >> 2, fresh_bid() & 3, lds, rep ? SCAN_VARIANT : 0);
    if (do_attn) for (;;) {
        if (fresh_tid() == 0) *sitem = (int)atomicAdd(ctr, 1u);
        __syncthreads();
        const int it = *sitem;
        __syncthreads();
        if (it >= 512) break;
        static constexpr unsigned char kLpt[64] = {31, 30, 29, 28, 27, 26, 25, 63, 24, 62, 23, 61, 60, 22, 59, 21, 58, 20, 57, 19, 56, 55, 18, 54, 17, 53, 16, 52, 15, 51, 50, 14, 49, 13, 48, 12, 47, 11, 46, 45, 10, 44, 9, 43, 8, 42, 7, 41, 40, 6, 39, 5, 38, 4, 37, 3, 36, 35, 2, 34, 1, 33, 0, 32};
        const int e_ = kLpt[it >> 3], h = it & 7, qt = e_ & 31;
        if (e_ < 32) attn_item<0>(a, b, h, qt, lds); else attn_item<1>(a, b, h, qt, lds);
        __syncthreads();
    }
}

__device__ __forceinline__ void phase_gdnpost(const Ctx& a, int l, int b) {
    const bf16_t* pa = (const bf16_t*)(a.ws + B_PROJ); bf16_t* br = (bf16_t*)(a.ws + B_BRANCH);
    const float* onorm = a.in(I_ONORM) + l * 128;
    const int tid = fresh_tid(), lane = tid & 63, wv = tid >> 6;
    float g[8];
#pragma unroll
    for (int e = 0; e < 8; ++e) g[e] = onorm[(lane & 15) * 8 + e];
    for (int tk = fresh_bid() * 8 + wv; tk < SEQ; tk += gridDim.x * 8) {
        bf16_t* op = br + ((size_t)b * SEQ + tk) * BR + 512 + lane * 8;
        u32x4 ov = *(const u32x4*)op;
        u32x4 zv = *(const u32x4*)(pa + (size_t)tk * PA + C_GZ + lane * 8);
        float x[8]; float ss = 0.f;
#pragma unroll
        for (int e = 0; e < 4; ++e) { x[2 * e] = lo_bf(ov[e]); x[2 * e + 1] = hi_bf(ov[e]); ss += x[2 * e] * x[2 * e] + x[2 * e + 1] * x[2 * e + 1]; }
        ss += __shfl_xor(ss, 1); ss += __shfl_xor(ss, 2); ss += __shfl_xor(ss, 4); ss += __shfl_xor(ss, 8);
        const float r = rsqrtf(ss * (1.f / 128.f) + EPS);
        u32x4 w;
#pragma unroll
        for (int e = 0; e < 4; ++e) w[e] = cvt_pk(x[2 * e] * r * g[2 * e] * siluf_(lo_bf(zv[e])), x[2 * e + 1] * r * g[2 * e + 1] * siluf_(hi_bf(zv[e])));
        *(u32x4*)op = w;
    }
}

#define XB_TMO      128
#define XB_XCNT(j)  (256  + 64 * (j))
#define XB_XSUB(j)  (1280 + 64 * (j))
#define XB_XGEN(j)  (2304 + 64 * (j))
#define XB_TOP      3328
#define XB_TOPGEN   3392
#define XB_SPIN_CAP (1u << 18)
__device__ __forceinline__ unsigned xb_ld(unsigned* p)              { return __hip_atomic_load(p, __ATOMIC_RELAXED, __HIP_MEMORY_SCOPE_AGENT); }
__device__ __forceinline__ unsigned xb_add(unsigned* p, unsigned v) { return __hip_atomic_fetch_add(p, v, __ATOMIC_RELAXED, __HIP_MEMORY_SCOPE_AGENT); }
__device__ __forceinline__ unsigned xb_xcc_id() { return (unsigned)__builtin_amdgcn_s_getreg((3 << 11) | 20) & 0xFu; }
#define XB_SPIN(cond, bar) do { unsigned _sp = 0; while (cond) { __builtin_amdgcn_s_sleep(1); \
    if ((++_sp & 255u) == 0u) { if (xb_ld(&(bar)[XB_TMO])) break; if (_sp > XB_SPIN_CAP) { atomicAdd(&(bar)[XB_TMO], 1u); break; } } } } while (0)
struct XcdBarrier { unsigned* bar; unsigned x; volatile LAS unsigned* st; };
__device__ __forceinline__ XcdBarrier xcd_barrier_post(unsigned* bar, volatile LAS unsigned* st) {
    XcdBarrier b; b.bar = bar; b.x = xb_xcc_id(); b.st = st;
    if (threadIdx.x == 0) (void)xb_add(&bar[XB_XCNT(b.x)], 1u);
    return b;
}
__device__ __forceinline__ void xcd_barrier_complete(unsigned* bar, unsigned x, unsigned& nloc, unsigned& nx) {
    const unsigned G = gridDim.x * gridDim.y * gridDim.z;
    unsigned sum, cnt, mine, sp = 0u;
    for (;;) {
        sum = 0u; cnt = 0u; mine = 0u;
#pragma unroll
        for (unsigned j = 0; j < 16; ++j) { const unsigned c = xb_ld(&bar[XB_XCNT(j)]); sum += c; cnt += (c > 0u) ? 1u : 0u; mine = (j == x) ? c : mine; }
        if (sum == G) break;
        __builtin_amdgcn_s_sleep(1);
        if ((++sp & 255u) == 0u) { if (xb_ld(&bar[XB_TMO])) break; if (sp > XB_SPIN_CAP) { atomicAdd(&bar[XB_TMO], 1u); break; } }
    }
    nloc = mine > 0u ? mine : 1u; nx = cnt > 0u ? cnt : 1u;
}
__device__ __forceinline__ void xcd_barrier(const XcdBarrier& b) {
    asm volatile("s_waitcnt vmcnt(0)" ::: "memory");
    __syncthreads();
    if (threadIdx.x == 0) {
        unsigned* bar = b.bar;
        __builtin_amdgcn_s_waitcnt(0);
        unsigned nloc = b.st[0], nx = b.st[1];
        if (nloc == 0u) { xcd_barrier_complete(bar, b.x, nloc, nx); b.st[0] = nloc; b.st[1] = nx; }
        const unsigned old = xb_add(&bar[XB_XSUB(b.x)], 1u);
        const unsigned gen = old / nloc;
        if (old + 1u == (gen + 1u) * nloc) {
            __builtin_amdgcn_fence(__ATOMIC_RELEASE, "agent");
            asm volatile("s_waitcnt vmcnt(0)" ::: "memory");
            const unsigned og = xb_add(&bar[XB_TOP], 1u);
            const unsigned tg = og / nx;
            if (og + 1u == (tg + 1u) * nx) xb_add(&bar[XB_TOPGEN], 1u);
            else XB_SPIN(xb_ld(&bar[XB_TOPGEN]) == tg, bar);
            __builtin_amdgcn_fence(__ATOMIC_ACQUIRE, "agent");
            xb_add(&bar[XB_XGEN(b.x)], 1u);
            asm volatile("s_waitcnt vmcnt(0)" ::: "memory");
        } else {
            XB_SPIN(xb_ld(&bar[XB_XGEN(b.x)]) == gen, bar);
            __builtin_amdgcn_fence(__ATOMIC_ACQUIRE, "agent");
            asm volatile("s_waitcnt vmcnt(0)" ::: "memory");
        }
    }
    __syncthreads();
}

constexpr int PH_PER_LAYER = 20, N_PHASES = 2 * PH_PER_LAYER;
__global__ void __launch_bounds__(NT, 2) mk_fwd(Args a_in) {
    extern __shared__ __attribute__((aligned(16))) unsigned char lds_raw[];
    LAS unsigned char* lds = (LAS unsigned char*)lds_raw;
    const Args& a0 = a_in;
    if (threadIdx.x < 23) ((const float**)(a0.ws + WS_PTRS))[threadIdx.x] = a0.in[threadIdx.x];
    volatile LAS unsigned* xst = (volatile LAS unsigned*)(lds + LDS_BYTES - 32);
    if (threadIdx.x < 4) xst[threadIdx.x] = 0u;
    __syncthreads();
    XcdBarrier xbar; xbar.bar = (unsigned*)(a0.ws + WS_BAR); xbar.x = 0; xbar.st = xst;
    if (a0.ph_hi - a0.ph_lo > 1) xbar = xcd_barrier_post((unsigned*)(a0.ws + WS_BAR), xst);
    if (a0.ph_lo < 0) cg::this_grid().sync();
    for (int p = a0.ph_lo; p < a0.ph_hi; ++p) {
        Ctx a;
        { size_t z_ = 0; asm volatile("" : "+s"(z_)); a.ws = a0.ws + z_; a.out = a0.out + z_; }
        a.in_ = (const float* const*)(a.ws + WS_PTRS);
        const int l = p / PH_PER_LAYER, q = p % PH_PER_LAYER;
        const int kind = (q >= 3 && q <= 14) ? 3 + (q - 3) % 6 : (q == 18 ? 1 : q);
        const int nrep = (kind == REP_Q) ? 2 : 1;
        for (int rep = 0; rep < nrep; ++rep) {
        if (rep) xcd_barrier(xbar);
        if (q == 0) phase_convert(a, l, lds);
        else if (q == 1 || q == 18) phase_ffn1(a, (const bf16_t*)(a.ws + (q == 1 ? W_FFA_IN : W_FFB_IN)), lds);
        else if (q == 2 || q == 17 || q == 19) {
            const bf16_t* A_ = (const bf16_t*)(a.ws + (q == 17 ? B_MERGED : B_ACT));
            const int K_ = (q == 17) ? DM : FF;
            const bf16_t* W_ = (const bf16_t*)(a.ws + (q == 2 ? W_FFA_OUT : (q == 17 ? W_OUT : W_FFB_OUT)));
            const float* xs_ = (q == 2 && l == 0) ? a.in(I_X) : a.out;
            phase_resid_gemm(a, A_, K_, W_, xs_, q == 17 ? 1.0f : 0.5f, lds);
        }
        else if (q >= 3 && q <= 14) {
            const int b = (q - 3) / 6, s = (q - 3) % 6;
            if (s == 0) phase_proj(a, b, lds);
            else if (s == 1) {
                for (int it = fresh_bid(); it < 512; it += gridDim.x) gdn_intra_item(a, l, it & 3, it >> 2, lds);
                phase_post1(a, l, lds);
            }
            else if (s == 2) { phase_mlaup(a, lds); kmean_items(a, lds); }
            else if (s == 3) {
                phase_post2(a, l, lds);
                for (int it = fresh_bid(); it < 128; it += gridDim.x) moba_gate_item(a, it, lds);
            }
            else if (s == 4) phase_mix(a, l, b, lds, rep);
            else phase_gdnpost(a, l, b);
        }
        else if (q == 15) phase_gates(a, lds);
        else phase_merge(a, lds);
        }
        if (p + 1 < a0.ph_hi) { xcd_barrier(xbar); for (int e_ = 0; e_ < EXTRA_SYNC; ++e_) xcd_barrier(xbar); }
    }
}

extern "C" void kernel_launch(void* const* d_in, const int* in_sizes, int n_in, void* d_out, int out_size, void* d_ws, size_t ws_size, hipStream_t stream) {
    static int grid = 0;
    if (grid == 0) {
        if (n_in != 23 || ws_size < WS_NEED) { fprintf(stderr, "kernel_launch: n_in %d ws %zu need %zu\n", n_in, ws_size, (size_t)WS_NEED); grid = -1; return; }
        int dev = 0, cus = 0, per_cu = 0;
        hipGetDevice(&dev);
        hipDeviceGetAttribute(&cus, hipDeviceAttributeMultiprocessorCount, dev);
        if (hipFuncSetAttribute((const void*)mk_fwd, hipFuncAttributeMaxDynamicSharedMemorySize, LDS_BYTES) != hipSuccess) { fprintf(stderr, "kernel_launch: hipFuncSetAttribute failed\n"); grid = -1; return; }
        hipOccupancyMaxActiveBlocksPerMultiprocessor(&per_cu, (const void*)mk_fwd, NT, LDS_BYTES);
        (void)hipGetLastError();
        if (per_cu < 1) per_cu = 1;
        grid = cus * 1;
    }
    if (grid < 0) return;
    Args a{};
    for (int i = 0; i < 23; ++i) a.in[i] = (const float*)d_in[i];
    a.out = (float*)d_out; a.ws = (unsigned char*)d_ws;
#if ONE_LAUNCH
    (void)hipMemsetAsync((unsigned char*)d_ws + WS_BAR, 0, WS_BAR_BYTES, stream);
    a.ph_lo = 0; a.ph_hi = N_PHASES;
    void* args[] = {&a};
    hipError_t e = hipLaunchCooperativeKernel((const void*)mk_fwd, dim3(grid), dim3(NT), args, LDS_BYTES, stream);
    if (e != hipSuccess) fprintf(stderr, "cooperative launch failed: %s (grid %d)\n", hipGetErrorString(e), grid);
#else
    for (int p = 0; p < N_PHASES; ++p) {
        a.ph_lo = p; a.ph_hi = p + 1;
        mk_fwd<<<dim3(grid), dim3(NT), LDS_BYTES, stream>>>(a);
    }
#endif
}
```

```cpp
#include <hip/hip_runtime.h>
#include <hip/hip_cooperative_groups.h>
#include <cstdio>
#include <cstdint>
namespace cg = cooperative_groups;

#ifndef REP_Q
#define REP_Q -1
#endif
#ifndef REP_MODE
#define REP_MODE 0
#endif
#ifndef SCAN_VARIANT
#define SCAN_VARIANT 0
#endif
#ifndef EXTRA_SYNC
#define EXTRA_SYNC 0
#endif
#ifndef ONE_LAUNCH
#define ONE_LAUNCH 1
#endif

typedef unsigned short bf16_t;
typedef short bf16x8 __attribute__((ext_vector_type(8)));
typedef short bf16x4 __attribute__((ext_vector_type(4)));
typedef float f32x4 __attribute__((ext_vector_type(4)));
typedef float f32x16 __attribute__((ext_vector_type(16)));
typedef unsigned u32x4 __attribute__((ext_vector_type(4)));
typedef unsigned u32x2 __attribute__((ext_vector_type(2)));
#define LAS __attribute__((address_space(3)))

constexpr int T = 16384, SEQ = 8192, DM = 1024, FF = 2816, FF2 = 5632, DIN = 7080;
constexpr int PA = 4096;
constexpr int NG = 3072;
constexpr int MR = 1792;
constexpr int BR = 1536;
constexpr int NT = 512;
constexpr int LDS_BYTES = 144 * 1024;
constexpr float EPS = 1e-6f;
constexpr float LOG2E = 1.4426950408889634f;
constexpr int C_CQ = 0, C_CKV = 256, C_KR = 384, C_GQ = 416, C_GK = 928, C_GV = 1440, C_GB = 1952, C_GA = 1956, C_GZ = 1960, C_MQ = 2472, C_MK = 2984, C_MV = 3496;

constexpr size_t AL(size_t x) { return (x + 255) & ~(size_t)255; }
constexpr size_t W_FFA_IN = 0;
constexpr size_t W_FFA_OUT = W_FFA_IN + (size_t)FF2 * DM * 2;
constexpr size_t W_INA = W_FFA_OUT + (size_t)DM * FF * 2;
constexpr size_t W_GATE = W_INA + (size_t)PA * DM * 2;
constexpr size_t W_MLA = W_GATE + (size_t)NG * DM * 2;
constexpr size_t W_BR = W_MLA + (size_t)MR * 384 * 2;
constexpr size_t W_OUT = W_BR + (size_t)DM * BR * 2;
constexpr size_t W_FFB_IN = W_OUT + (size_t)DM * DM * 2;
constexpr size_t W_FFB_OUT = W_FFB_IN + (size_t)FF2 * DM * 2;
constexpr size_t WS_XB = W_FFB_OUT + (size_t)DM * FF * 2;
constexpr size_t WS_SSQ = WS_XB + (size_t)T * DM * 2;
constexpr size_t WS_TAB64 = WS_SSQ + (size_t)T * 4 * 4;
constexpr size_t WS_TAB32 = WS_TAB64 + (size_t)SEQ * 32 * 8;
constexpr size_t WS_RQ = WS_TAB32 + (size_t)SEQ * 16 * 8;
constexpr size_t WS_RKV = WS_RQ + (size_t)SEQ * 4;
constexpr size_t WS_KMEAN = WS_RKV + (size_t)SEQ * 4;
constexpr size_t WS_MASK = WS_KMEAN + (size_t)8 * 32 * 64 * 4;
constexpr size_t WS_GLAST = WS_MASK + (size_t)8 * SEQ * 4;
constexpr size_t WS_CTR = WS_GLAST + (size_t)4 * 128 * 4;
constexpr size_t WS_PTRS = WS_CTR + 512;
constexpr size_t WS_BAR = AL(WS_CTR + 1024);
constexpr size_t WS_BAR_BYTES = 3456 * 4;
constexpr size_t WS_BIG = AL(WS_BAR + WS_BAR_BYTES);
constexpr size_t B_ACT = WS_BIG;
constexpr size_t B_BRANCH = WS_BIG;
constexpr size_t B_PROJ = B_BRANCH + (size_t)T * BR * 2;
constexpr size_t B_MLA = B_PROJ + (size_t)SEQ * PA * 2;
constexpr size_t B_KROPE = B_MLA + (size_t)SEQ * MR * 2;
constexpr size_t B_GU = B_KROPE + (size_t)SEQ * 8 * 32 * 2;
constexpr size_t B_GW = B_GU + (size_t)SEQ * 512 * 2;
constexpr size_t B_GQD = B_GW + (size_t)SEQ * 512 * 2;
constexpr size_t B_GKT = B_GQD + (size_t)SEQ * 512 * 2;
constexpr size_t B_GQK = B_GKT + (size_t)SEQ * 512 * 2;
constexpr size_t B_END1 = B_GQK + (size_t)4 * 128 * 64 * 64 * 2;
constexpr size_t B_GATES = B_PROJ;
constexpr size_t B_MERGED = B_GATES + (size_t)T * NG * 2;
constexpr size_t B_END2 = B_MERGED + (size_t)T * DM * 2;
constexpr size_t B_END3 = B_ACT + (size_t)T * FF * 2;
constexpr size_t WS_NEED = (B_END1 > B_END2 ? (B_END1 > B_END3 ? B_END1 : B_END3) : (B_END2 > B_END3 ? B_END2 : B_END3));

struct Args {
    const float* in[23];
    float* out;
    unsigned char* ws;
    int ph_lo, ph_hi;
};
template <class T> __device__ __forceinline__ T* as_global(T* p) { return (T*)(__attribute__((address_space(1))) T*)p; }
struct Ctx { const float* const* in_; float* out; unsigned char* ws;
    __device__ __forceinline__ const float* in(int i) const { return as_global(in_[i]); } };
enum { I_X = 0, I_FFA_NORM, I_FFA_WIN, I_FFA_WOUT, I_MIX_NORM, I_WIN, I_CQ_NORM, I_CKV_NORM, I_WUQ, I_WUKV, I_QN, I_KN, I_CONV, I_ALOG, I_DTB, I_ONORM,
       I_MQN, I_MKN, I_WBR, I_WOUT, I_FFB_NORM, I_FFB_WIN, I_FFB_WOUT };

__device__ __forceinline__ float bf2f(bf16_t h) { return __uint_as_float(((unsigned)h) << 16); }
typedef __bf16 bf16x2_t __attribute__((ext_vector_type(2)));
typedef float f32x2_t __attribute__((ext_vector_type(2)));
__device__ __forceinline__ unsigned cvt_pk(float lo, float hi) { f32x2_t v = {lo, hi}; bf16x2_t b = __builtin_convertvector(v, bf16x2_t); return __builtin_bit_cast(unsigned, b); }
__device__ __forceinline__ bf16_t f2bf(float f) { return (bf16_t)(cvt_pk(f, 0.f) & 0xffffu); }
__device__ __forceinline__ float lo_bf(unsigned u) { return __uint_as_float(u << 16); }
__device__ __forceinline__ float hi_bf(unsigned u) { return __uint_as_float(u & 0xffff0000u); }
__device__ __forceinline__ float wave_sum(float v) {
#pragma unroll
    for (int o = 32; o > 0; o >>= 1) v += __shfl_xor(v, o);
    return v;
}
__device__ __forceinline__ float sigmoidf_(float x) { return __builtin_amdgcn_rcpf(1.f + __builtin_amdgcn_exp2f(-1.4426950408889634f * x)); }
__device__ __forceinline__ float siluf_(float x) { return x * __builtin_amdgcn_rcpf(1.f + __builtin_amdgcn_exp2f(-1.4426950408889634f * x)); }

__device__ __forceinline__ int fresh_tid() { int t; asm volatile("v_mov_b32 %0, %1" : "=v"(t) : "v"(threadIdx.x)); return t; }
__device__ __forceinline__ int fresh_bid() { int t; asm volatile("s_mov_b32 %0, %1" : "=s"(t) : "s"(blockIdx.x)); return t; }
constexpr int BK = 64, HALF = 128, HTB = HALF * BK * 2;
__device__ __forceinline__ int lds_byte(int r, int c) {
    int st = (r >> 4) * 2 + (c >> 5), rr = r & 15, cc = c & 31, ob = rr * 64 + cc * 2;
    return st * 1024 + (ob ^ (((ob >> 9) & 1) << 5));
}
__device__ __forceinline__ void stage_rc(int b, int& R, int& C) {
    int st = b / 1024, sb = b % 1024, swz = sb ^ (((sb >> 9) & 1) << 5);
    R = (st >> 1) * 16 + swz / 64; C = (st & 1) * 32 + (swz % 64) / 2;
}

typedef f32x4 Acc[2][2][4][2];

template <bool PRE = false>
__device__ __forceinline__ void gemm_kloop(Acc& acc, const bf16_t* __restrict__ A, int lda, const bf16_t* __restrict__ Bt, int ldb,
                                           int brow, int bcol, int nt, LAS unsigned char* lds) {
    const int tid = fresh_tid();
    const int wid = tid >> 6, lane = tid & 63, wr = wid >> 2, wc = wid & 3, fr = lane & 15, fq = lane >> 4;
    const int wvu = __builtin_amdgcn_readfirstlane(tid >> 6);
    unsigned offA, offB;
    { int _r, _c; stage_rc(tid * 16, _r, _c); offA = (unsigned)(_r * lda + _c) * 2u; offB = (unsigned)(_r * ldb + _c) * 2u; }
#define SAo(b, h) (((b) * 2 + (h)) * HTB)
#define SBo(b, h) ((4 + (b) * 2 + (h)) * HTB)
#define STAGE(Poff, BASE, LD, br, kt, OFF) do { int _kt = (kt), _wv = wvu; asm volatile("" : "+s"(_kt), "+s"(_wv));     \
    _Pragma("unroll") for (int _i = 0; _i < 2; ++_i) { const char* _g = (const char*)((BASE) + (long)((br) + _i * 64) * (LD) + (long)_kt * BK); \
      __builtin_amdgcn_global_load_lds((const unsigned*)(_g + OFF), (LAS unsigned*)(lds + (Poff) + _wv * 1024 + _i * 8192), 16, 0, 0); } } while (0)
#define LDA(dst, b, h) _Pragma("unroll") for (int m = 0; m < 4; ++m) _Pragma("unroll") for (int k = 0; k < 2; ++k) \
    dst[m][k] = *reinterpret_cast<const LAS bf16x8*>(lds + SAo(b, h) + lds_byte(wr * 64 + m * 16 + fr, k * 32 + fq * 8))
#define LDB(dst, b, h) _Pragma("unroll") for (int n = 0; n < 2; ++n) _Pragma("unroll") for (int k = 0; k < 2; ++k) \
    dst[n][k] = *reinterpret_cast<const LAS bf16x8*>(lds + SBo(b, h) + lds_byte(wc * 32 + n * 16 + fr, k * 32 + fq * 8))
#define MMA(ai, bj, At_, Bt_) do { __builtin_amdgcn_s_setprio(1); \
    _Pragma("unroll") for (int m = 0; m < 4; ++m) _Pragma("unroll") for (int n = 0; n < 2; ++n) _Pragma("unroll") for (int k = 0; k < 2; ++k) \
      acc[ai][bj][m][n] = __builtin_amdgcn_mfma_f32_16x16x32_bf16(Bt_[n][k], At_[m][k], acc[ai][bj][m][n], 0, 0, 0); \
    __builtin_amdgcn_s_setprio(0); } while (0)
#define WAIT_V(n) asm volatile("s_waitcnt vmcnt(" #n ")" ::: "memory")
#define WAIT_L(n) asm volatile("s_waitcnt lgkmcnt(" #n ")" ::: "memory")
#define BAR __builtin_amdgcn_s_barrier()
#define SCHED __builtin_amdgcn_sched_barrier(0)
    bf16x8 At[4][2], B0[2][2], B1[2][2];
    if (!PRE) {
    STAGE(SBo(0, 0), Bt, ldb, bcol, 0, offB); STAGE(SAo(0, 0), A, lda, brow, 0, offA);
    STAGE(SBo(0, 1), Bt, ldb, bcol + HALF, 0, offB); STAGE(SAo(0, 1), A, lda, brow + HALF, 0, offA);
    }
    if (wr == 1) BAR;
    WAIT_V(4); BAR;
    STAGE(SBo(1, 0), Bt, ldb, bcol, 1, offB); STAGE(SAo(1, 0), A, lda, brow, 1, offA); STAGE(SBo(1, 1), Bt, ldb, bcol + HALF, 1, offB);
    WAIT_V(6); BAR;
    for (int t = 0; t < nt - 2; t += 2) {
        LDB(B0, 0, 0); SCHED; LDA(At, 0, 0); STAGE(SAo(1, 1), A, lda, brow + HALF, t + 1, offA);
        WAIT_L(8); BAR; WAIT_L(0); MMA(0, 0, At, B0); BAR; SCHED;
        LDB(B1, 0, 1); STAGE(SBo(0, 0), Bt, ldb, bcol, t + 2, offB);
        BAR; WAIT_L(0); MMA(0, 1, At, B1); BAR;
        LDA(At, 0, 1); STAGE(SAo(0, 0), A, lda, brow, t + 2, offA);
        BAR; WAIT_L(0); MMA(1, 0, At, B0); BAR; SCHED;
        STAGE(SBo(0, 1), Bt, ldb, bcol + HALF, t + 2, offB);
        WAIT_V(6); BAR; MMA(1, 1, At, B1); BAR;
        LDB(B0, 1, 0); SCHED; LDA(At, 1, 0); STAGE(SAo(0, 1), A, lda, brow + HALF, t + 2, offA);
        WAIT_L(8); BAR; WAIT_L(0); MMA(0, 0, At, B0); BAR; SCHED;
        LDB(B1, 1, 1); STAGE(SBo(1, 0), Bt, ldb, bcol, t + 3, offB);
        BAR; WAIT_L(0); MMA(0, 1, At, B1); BAR;
        LDA(At, 1, 1); STAGE(SAo(1, 0), A, lda, brow, t + 3, offA);
        BAR; WAIT_L(0); MMA(1, 0, At, B0); BAR; SCHED;
        STAGE(SBo(1, 1), Bt, ldb, bcol + HALF, t + 3, offB);
        WAIT_V(6); BAR; MMA(1, 1, At, B1); BAR;
    }
    { LDB(B0, 0, 0); LDA(At, 0, 0); STAGE(SAo(1, 1), A, lda, brow + HALF, nt - 1, offA);
      BAR; WAIT_L(0); MMA(0, 0, At, B0); BAR;
      LDB(B1, 0, 1); BAR; WAIT_L(0); MMA(0, 1, At, B1); BAR;
      LDA(At, 0, 1); WAIT_V(4); BAR; WAIT_L(0); MMA(1, 0, At, B0); MMA(1, 1, At, B1); BAR; }
    { LDB(B0, 1, 0); LDA(At, 1, 0); WAIT_V(2); BAR; WAIT_L(0); MMA(0, 0, At, B0); BAR;
      LDB(B1, 1, 1); WAIT_V(0); BAR; WAIT_L(0); MMA(0, 1, At, B1); BAR;
      LDA(At, 1, 1); BAR; WAIT_L(0); MMA(1, 0, At, B0); MMA(1, 1, At, B1); BAR; }
    if (wr == 0) BAR;
}

__device__ __forceinline__ void gemm_stage_first(const bf16_t* __restrict__ A, int lda, const bf16_t* __restrict__ Bt, int ldb, int brow, int bcol, LAS unsigned char* lds) {
    const int tid = fresh_tid();
    const int wvu = __builtin_amdgcn_readfirstlane(tid >> 6);
    unsigned offA, offB;
    { int _r, _c; stage_rc(tid * 16, _r, _c); offA = (unsigned)(_r * lda + _c) * 2u; offB = (unsigned)(_r * ldb + _c) * 2u; }
    STAGE(SBo(0, 0), Bt, ldb, bcol, 0, offB); STAGE(SAo(0, 0), A, lda, brow, 0, offA);
    STAGE(SBo(0, 1), Bt, ldb, bcol + HALF, 0, offB); STAGE(SAo(0, 1), A, lda, brow + HALF, 0, offA);
}

#define ACC_ZERO(acc) _Pragma("unroll") for (int _a = 0; _a < 2; ++_a) _Pragma("unroll") for (int _b = 0; _b < 2; ++_b) _Pragma("unroll") for (int _m = 0; _m < 4; ++_m) \
    _Pragma("unroll") for (int _n = 0; _n < 2; ++_n) acc[_a][_b][_m][_n] = (f32x4){0.f, 0.f, 0.f, 0.f}

struct TileIdx { int tid, wid, lane, wr, wc, fr, fq; };
__device__ __forceinline__ TileIdx tile_idx() { TileIdx t; t.tid = fresh_tid(); t.wid = t.tid >> 6; t.lane = t.tid & 63; t.wr = t.wid >> 2; t.wc = t.wid & 3; t.fr = t.lane & 15; t.fq = t.lane >> 4; return t; }

__device__ __forceinline__ float rstd_from_ssq(const float* ssq, int row) {
    f32x4 s = *(const f32x4*)(ssq + (size_t)row * 4);
    return rsqrtf((s[0] + s[1] + s[2] + s[3]) * (1.f / 1024.f) + EPS);
}

__device__ __forceinline__ void epi_swiglu(Acc& acc, int pm, int pn, const float* ssq, bf16_t* act) {
    TileIdx t = tile_idx();
    float rsv[2][4];
#pragma unroll
    for (int ai = 0; ai < 2; ++ai)
#pragma unroll
        for (int m = 0; m < 4; ++m) rsv[ai][m] = rstd_from_ssq(ssq, pm * 256 + ai * 128 + t.wr * 64 + m * 16 + t.fr);
#pragma unroll
    for (int ai = 0; ai < 2; ++ai)
#pragma unroll
        for (int m = 0; m < 4; ++m) {
            int row = pm * 256 + ai * 128 + t.wr * 64 + m * 16 + t.fr;
            float rs = rsv[ai][m];
#pragma unroll
            for (int n = 0; n < 2; ++n) {
                float o[4];
#pragma unroll
                for (int j = 0; j < 4; ++j) { float g = acc[ai][0][m][n][j] * rs, u = acc[ai][1][m][n][j] * rs; o[j] = siluf_(g) * u; }
                u32x2 w; w[0] = cvt_pk(o[0], o[1]); w[1] = cvt_pk(o[2], o[3]);
                *(u32x2*)(act + (size_t)row * FF + pn * 128 + t.wc * 32 + n * 16 + t.fq * 4) = w;
            }
        }
}
__device__ __forceinline__ void epi_resid(Acc& acc, int pm, int pn, const float* xsrc, float* xdst, bf16_t* xb, float* ssq, float alpha, LAS unsigned char* lds) {
    TileIdx t = tile_idx();
    LAS float* red = (LAS float*)lds;
#pragma unroll
    for (int ai = 0; ai < 2; ++ai)
#pragma unroll
        for (int mp = 0; mp < 2; ++mp) {
            f32x4 xs[2][2][2];
#pragma unroll
            for (int mm = 0; mm < 2; ++mm)
#pragma unroll
                for (int bj = 0; bj < 2; ++bj)
#pragma unroll
                    for (int n = 0; n < 2; ++n) {
                        const int row = pm * 256 + ai * 128 + t.wr * 64 + (mp * 2 + mm) * 16 + t.fr;
                        xs[mm][bj][n] = *(const f32x4*)(xsrc + (size_t)row * DM + pn * 256 + bj * 128 + t.wc * 32 + n * 16 + t.fq * 4);
                    }
#pragma unroll
            for (int mm = 0; mm < 2; ++mm) {
                const int m = mp * 2 + mm;
                const int rl = ai * 128 + t.wr * 64 + m * 16 + t.fr;
                const int row = pm * 256 + rl;
                float ss = 0.f;
#pragma unroll
                for (int bj = 0; bj < 2; ++bj)
#pragma unroll
                    for (int n = 0; n < 2; ++n) {
                        size_t off = (size_t)row * DM + pn * 256 + bj * 128 + t.wc * 32 + n * 16 + t.fq * 4;
                        f32x4 v = xs[mm][bj][n] + acc[ai][bj][m][n] * alpha;
                        *(f32x4*)(xdst + off) = v;
                        u32x2 w; w[0] = cvt_pk(v[0], v[1]); w[1] = cvt_pk(v[2], v[3]);
                        *(u32x2*)(xb + off) = w;
                        ss += v[0] * v[0] + v[1] * v[1] + v[2] * v[2] + v[3] * v[3];
                    }
                ss += __shfl_xor(ss, 16); ss += __shfl_xor(ss, 32);
                if (t.fq == 0) red[t.wc * 256 + rl] = ss;
            }
        }
    __syncthreads();
    if (t.tid < 256) ssq[(size_t)(pm * 256 + t.tid) * 4 + pn] = red[t.tid] + red[256 + t.tid] + red[512 + t.tid] + red[768 + t.tid];
}
template <int MODE>
__device__ __forceinline__ void epi_scaled(Acc& acc, int pm, int pn, const float* ssq, const float* rq, const float* rkv, bf16_t* out, int ldo) {
    TileIdx t = tile_idx();
    float rsv[2][4];
#pragma unroll
    for (int ai = 0; ai < 2; ++ai)
#pragma unroll
        for (int m = 0; m < 4; ++m) {
            const int row = pm * 256 + ai * 128 + t.wr * 64 + m * 16 + t.fr;
            if (MODE == 1) rsv[ai][m] = (pn < 3) ? rq[row] : rkv[row];
            else rsv[ai][m] = rstd_from_ssq(ssq, row);
        }
#pragma unroll
    for (int ai = 0; ai < 2; ++ai)
#pragma unroll
        for (int m = 0; m < 4; ++m) {
            int row = pm * 256 + ai * 128 + t.wr * 64 + m * 16 + t.fr;
            const float rs = rsv[ai][m];
#pragma unroll
            for (int bj = 0; bj < 2; ++bj)
#pragma unroll
                for (int n = 0; n < 2; ++n) {
                    f32x4 v = acc[ai][bj][m][n] * rs;
                    if (MODE == 2) {
#pragma unroll
                        for (int j = 0; j < 4; ++j) v[j] = sigmoidf_(v[j]);
                    }
                    u32x2 w; w[0] = cvt_pk(v[0], v[1]); w[1] = cvt_pk(v[2], v[3]);
                    *(u32x2*)(out + (size_t)row * ldo + pn * 256 + bj * 128 + t.wc * 32 + n * 16 + t.fq * 4) = w;
                }
        }
}

__device__ __forceinline__ void tile_of(int w, int nM, int& pm, int& pn) { pm = w % nM; pn = w / nM; }

struct CJob { const float* src; int ldsrc, K, Nvalid, Ntot; bf16_t* dst; int lddst, koff; const float* gain; int perm; };
__device__ __forceinline__ CJob get_job(int j, const Ctx& a, int l) {
    unsigned char* ws = a.ws; CJob c{}; c.koff = 0; c.gain = nullptr; c.perm = 0;
    switch (j) {
    case 0: c.src = a.in(I_FFA_WIN) + (size_t)l * DM * FF2; c.ldsrc = FF2; c.K = DM; c.Nvalid = c.Ntot = FF2; c.dst = (bf16_t*)(ws + W_FFA_IN); c.lddst = DM; c.gain = a.in(I_FFA_NORM) + l * DM; c.perm = 1; break;
    case 1: c.src = a.in(I_FFA_WOUT) + (size_t)l * FF * DM; c.ldsrc = DM; c.K = FF; c.Nvalid = c.Ntot = DM; c.dst = (bf16_t*)(ws + W_FFA_OUT); c.lddst = FF; break;
    case 2: c.src = a.in(I_WIN) + (size_t)l * DM * DIN; c.ldsrc = DIN; c.K = DM; c.Nvalid = 4008; c.Ntot = PA; c.dst = (bf16_t*)(ws + W_INA); c.lddst = DM; c.gain = a.in(I_MIX_NORM) + l * DM; break;
    case 3: c.src = a.in(I_WIN) + (size_t)l * DM * DIN + 4008; c.ldsrc = DIN; c.K = DM; c.Nvalid = c.Ntot = NG; c.dst = (bf16_t*)(ws + W_GATE); c.lddst = DM; c.gain = a.in(I_MIX_NORM) + l * DM; break;
    case 4: case 5: case 6: { int n = j - 4; c.src = a.in(I_WBR) + (size_t)(l * 3 + n) * 512 * DM; c.ldsrc = DM; c.K = 512; c.Nvalid = c.Ntot = DM; c.dst = (bf16_t*)(ws + W_BR); c.lddst = BR; c.koff = n * 512; break; }
    case 7: c.src = a.in(I_WOUT) + (size_t)l * DM * DM; c.ldsrc = DM; c.K = DM; c.Nvalid = c.Ntot = DM; c.dst = (bf16_t*)(ws + W_OUT); c.lddst = DM; break;
    case 8: c.src = a.in(I_FFB_WIN) + (size_t)l * DM * FF2; c.ldsrc = FF2; c.K = DM; c.Nvalid = c.Ntot = FF2; c.dst = (bf16_t*)(ws + W_FFB_IN); c.lddst = DM; c.gain = a.in(I_FFB_NORM) + l * DM; c.perm = 1; break;
    default: c.src = a.in(I_FFB_WOUT) + (size_t)l * FF * DM; c.ldsrc = DM; c.K = FF; c.Nvalid = c.Ntot = DM; c.dst = (bf16_t*)(ws + W_FFB_OUT); c.lddst = FF; break;
    }
    return c;
}

__device__ __forceinline__ void phase_convert(const Ctx& a, int l, LAS unsigned char* lds) {
    const int tid = fresh_tid();
    LAS float* tile = (LAS float*)lds;
    int base = 0;
    for (int j = 0; j < 10; ++j) {
        CJob c = get_job(j, a, l);
        const int nkt = c.K / 64, nnt = c.Ntot / 64, ntile = nkt * nnt;
        int first = (int)((fresh_bid() + gridDim.x - (base % gridDim.x)) % gridDim.x);
        float pv[8];
#define CV_LOAD(ii) do { const int kt_ = (ii) / nnt, ntl_ = (ii) % nnt; const int n_ = ntl_ * 64 + (tid & 63); const int ncl_ = n_ < c.Nvalid ? n_ : c.Nvalid - 1; \
            const float* sp_ = c.src + (size_t)(kt_ * 64 + (tid >> 6)) * c.ldsrc + ncl_; \
            _Pragma("unroll") for (int it = 0; it < 8; ++it) pv[it] = sp_[(size_t)(it * 8) * c.ldsrc]; \
            if (c.gain) { const float* gp_ = c.gain + kt_ * 64 + (tid >> 6); _Pragma("unroll") for (int it = 0; it < 8; ++it) pv[it] *= gp_[it * 8]; } \
            if (n_ >= c.Nvalid) { _Pragma("unroll") for (int it = 0; it < 8; ++it) pv[it] = 0.f; } } while (0)
        if (first < ntile) CV_LOAD(first);
        for (int i = first; i < ntile; i += gridDim.x) {
            const int kt = i / nnt, ntl = i % nnt, k0 = kt * 64, n0 = ntl * 64;
#pragma unroll
            for (int it = 0; it < 8; ++it) tile[((tid >> 6) + it * 8) * 65 + (tid & 63)] = pv[it];
            __syncthreads();
            if (i + (int)gridDim.x < ntile) CV_LOAD(i + gridDim.x);
            {
                int nn = tid >> 3, kc = (tid & 7) * 8, n = n0 + nn, row = n;
                if (c.perm) { if (n < FF) row = (n / 128) * 256 + (n % 128); else { int jn = n - FF; row = (jn / 128) * 256 + 128 + (jn % 128); } }
                u32x4 w;
                w[0] = cvt_pk(tile[(kc + 0) * 65 + nn], tile[(kc + 1) * 65 + nn]);
                w[1] = cvt_pk(tile[(kc + 2) * 65 + nn], tile[(kc + 3) * 65 + nn]);
                w[2] = cvt_pk(tile[(kc + 4) * 65 + nn], tile[(kc + 5) * 65 + nn]);
                w[3] = cvt_pk(tile[(kc + 6) * 65 + nn], tile[(kc + 7) * 65 + nn]);
                *(u32x4*)(c.dst + (size_t)row * c.lddst + c.koff + k0 + kc) = w;
            }
            __syncthreads();
        }
        base += ntile;
    }
    {
        const float* wuq = a.in(I_WUQ) + (size_t)l * 256 * 768; const float* wukv = a.in(I_WUKV) + (size_t)l * 128 * 1024;
        const float* gq = a.in(I_CQ_NORM) + l * 256; const float* gkv = a.in(I_CKV_NORM) + l * 128;
        bf16_t* dst = (bf16_t*)(a.ws + W_MLA);
        for (int ch = fresh_bid() * NT + tid; ch < MR * 48; ch += gridDim.x * NT) {
            int n = ch % MR, kc = (ch / MR) * 8;
            float v[8];
#pragma unroll
            for (int e = 0; e < 8; ++e) {
                const int k = kc + e;
                const int kq_ = k < 256 ? k : 255, nq_ = n < 768 ? n : 767, kk_ = k >= 256 ? k - 256 : 0, nk_ = n >= 768 ? n - 768 : 0;
                const float xq = gq[kq_] * wuq[(size_t)kq_ * 768 + nq_], xk = gkv[kk_] * wukv[(size_t)kk_ * 1024 + nk_];
                v[e] = (n < 768) ? (k < 256 ? xq : 0.f) : (k >= 256 ? xk : 0.f);
            }
            u32x4 w; w[0] = cvt_pk(v[0], v[1]); w[1] = cvt_pk(v[2], v[3]); w[2] = cvt_pk(v[4], v[5]); w[3] = cvt_pk(v[6], v[7]);
            *(u32x4*)(dst + (size_t)n * 384 + kc) = w;
        }
    }
    if (l == 0) {
        float2* t64 = (float2*)(a.ws + WS_TAB64); float2* t32 = (float2*)(a.ws + WS_TAB32);
        for (int e = fresh_bid() * NT + tid; e < SEQ * 48; e += gridDim.x * NT) {
            int s = e / 48, i = e % 48;
            float invf; float2* dst;
            if (i < 32) { invf = exp2f(-(float)(2 * i) / 64.f * 13.287712379549449f); dst = t64 + s * 32 + i; }
            else { int ii = i - 32; invf = exp2f(-(float)(2 * ii) / 32.f * 13.287712379549449f); dst = t32 + s * 16 + ii; }
            float ang = (float)s * invf;
            double rev = (double)ang * 0.15915494309189535; rev -= floor(rev);
            float fr = (float)rev;
            *dst = make_float2(__builtin_amdgcn_cosf(fr), __builtin_amdgcn_sinf(fr));
        }
        const float* x = a.in(I_X); bf16_t* xb = (bf16_t*)(a.ws + WS_XB); float* ssq = (float*)(a.ws + WS_SSQ);
        for (int r2 = fresh_bid(); r2 < T / 2; r2 += gridDim.x) {
            int row = r2 * 2 + (tid >> 8), tt = tid & 255;
            f32x4 v = *(const f32x4*)(x + (size_t)row * DM + tt * 4);
            u32x2 w; w[0] = cvt_pk(v[0], v[1]); w[1] = cvt_pk(v[2], v[3]);
            *(u32x2*)(xb + (size_t)row * DM + tt * 4) = w;
            float ss = wave_sum(v[0] * v[0] + v[1] * v[1] + v[2] * v[2] + v[3] * v[3]);
            if ((tid & 63) == 0) ssq[(size_t)row * 4 + (tt >> 6)] = ss;
        }
        if (fresh_bid() == 0 && tid < 64) ((unsigned*)(a.ws + WS_CTR))[tid] = 0u;
    }
}

__device__ __forceinline__ void phase_ffn1(const Ctx& a, const bf16_t* W, LAS unsigned char* lds) {
    const bf16_t* xb = (const bf16_t*)(a.ws + WS_XB); const float* ssq = (const float*)(a.ws + WS_SSQ); bf16_t* act = (bf16_t*)(a.ws + B_ACT);
    const int nM = T / 256, ntile = nM * (FF2 / 256);
    { const int w0 = fresh_bid(); if (w0 < ntile) { int pm0, pn0; tile_of(w0, nM, pm0, pn0); gemm_stage_first(xb, DM, W, DM, pm0 * 256, pn0 * 256, lds); } }
    for (int w = fresh_bid(); w < ntile; w += gridDim.x) {
        int pm, pn; tile_of(w, nM, pm, pn);
        Acc acc; ACC_ZERO(acc);
        gemm_kloop<true>(acc, xb, DM, W, DM, pm * 256, pn * 256, DM / 64, lds);
        { const int wn = w + (int)gridDim.x; if (wn < ntile) { int pm2, pn2; tile_of(wn, nM, pm2, pn2); gemm_stage_first(xb, DM, W, DM, pm2 * 256, pn2 * 256, lds); } }
        epi_swiglu(acc, pm, pn, ssq, act);
        __syncthreads();
    }
}
__device__ __forceinline__ void phase_resid_gemm(const Ctx& a, const bf16_t* A, int K, const bf16_t* W, const float* xsrc, float alpha, LAS unsigned char* lds) {
    bf16_t* xb = (bf16_t*)(a.ws + WS_XB); float* ssq = (float*)(a.ws + WS_SSQ);
    const int nM = T / 256, ntile = nM * (DM / 256);
    for (int w = fresh_bid(); w < ntile; w += gridDim.x) {
        int pm, pn; tile_of(w, nM, pm, pn);
        Acc acc; ACC_ZERO(acc);
        gemm_kloop(acc, A, K, W, K, pm * 256, pn * 256, K / 64, lds);
        __syncthreads();
        epi_resid(acc, pm, pn, xsrc, a.out, xb, ssq, alpha, lds);
        __syncthreads();
    }
}
__device__ __forceinline__ void phase_proj(const Ctx& a, int b, LAS unsigned char* lds) {
    const bf16_t* xb = (const bf16_t*)(a.ws + WS_XB) + (size_t)b * SEQ * DM; const float* ssq = (const float*)(a.ws + WS_SSQ) + (size_t)b * SEQ * 4;
    const bf16_t* W = (const bf16_t*)(a.ws + W_INA); bf16_t* pa = (bf16_t*)(a.ws + B_PROJ);
    const int nM = SEQ / 256, ntile = nM * (PA / 256);
    { const int w0 = fresh_bid(); if (w0 < ntile) { int pm0, pn0; tile_of(w0, nM, pm0, pn0); gemm_stage_first(xb, DM, W, DM, pm0 * 256, pn0 * 256, lds); } }
    for (int w = fresh_bid(); w < ntile; w += gridDim.x) {
        int pm, pn; tile_of(w, nM, pm, pn);
        Acc acc; ACC_ZERO(acc);
        gemm_kloop<true>(acc, xb, DM, W, DM, pm * 256, pn * 256, DM / 64, lds);
        { const int wn = w + (int)gridDim.x; if (wn < ntile) { int pm2, pn2; tile_of(wn, nM, pm2, pn2); gemm_stage_first(xb, DM, W, DM, pm2 * 256, pn2 * 256, lds); } }
        epi_scaled<0>(acc, pm, pn, ssq, nullptr, nullptr, pa, PA);
        __syncthreads();
    }
}
__device__ __forceinline__ void phase_mlaup(const Ctx& a, LAS unsigned char* lds) {
    const bf16_t* pa = (const bf16_t*)(a.ws + B_PROJ); const bf16_t* W = (const bf16_t*)(a.ws + W_MLA); bf16_t* mr = (bf16_t*)(a.ws + B_MLA);
    const float* rq = (const float*)(a.ws + WS_RQ); const float* rkv = (const float*)(a.ws + WS_RKV);
    const int nM = SEQ / 256, ntile = nM * (MR / 256);
    for (int w = fresh_bid(); w < ntile; w += gridDim.x) {
        int pm, pn; tile_of(w, nM, pm, pn);
        Acc acc; ACC_ZERO(acc);
        gemm_kloop(acc, pa, PA, W, 384, pm * 256, pn * 256, 384 / 64, lds);
        epi_scaled<1>(acc, pm, pn, nullptr, rq, rkv, mr, MR);
        __syncthreads();
    }
}
__device__ __forceinline__ void phase_gates(const Ctx& a, LAS unsigned char* lds) {
    const bf16_t* xb = (const bf16_t*)(a.ws + WS_XB); const float* ssq = (const float*)(a.ws + WS_SSQ);
    const bf16_t* W = (const bf16_t*)(a.ws + W_GATE); bf16_t* g = (bf16_t*)(a.ws + B_GATES);
    const int nM = T / 256, ntile = nM * (NG / 256);
    { const int w0 = fresh_bid(); if (w0 < ntile) { int pm0, pn0; tile_of(w0, nM, pm0, pn0); gemm_stage_first(xb, DM, W, DM, pm0 * 256, pn0 * 256, lds); } }
    for (int w = fresh_bid(); w < ntile; w += gridDim.x) {
        int pm, pn; tile_of(w, nM, pm, pn);
        Acc acc; ACC_ZERO(acc);
        gemm_kloop<true>(acc, xb, DM, W, DM, pm * 256, pn * 256, DM / 64, lds);
        { const int wn = w + (int)gridDim.x; if (wn < ntile) { int pm2, pn2; tile_of(wn, nM, pm2, pn2); gemm_stage_first(xb, DM, W, DM, pm2 * 256, pn2 * 256, lds); } }
        epi_scaled<2>(acc, pm, pn, ssq, nullptr, nullptr, g, NG);
        __syncthreads();
    }
}
__device__ __forceinline__ void phase_merge(const Ctx& a, LAS unsigned char* lds) {
    const bf16_t* br = (const bf16_t*)(a.ws + B_BRANCH); const bf16_t* W = (const bf16_t*)(a.ws + W_BR);
    const bf16_t* g = (const bf16_t*)(a.ws + B_GATES); bf16_t* mg = (bf16_t*)(a.ws + B_MERGED);
    const int nM = T / 256, ntile = nM * (DM / 256);
    for (int w = fresh_bid(); w < ntile; w += gridDim.x) {
        int pm, pn; tile_of(w, nM, pm, pn);
        Acc acc; ACC_ZERO(acc);
#pragma unroll 1
        for (int seg = 0; seg < 3; ++seg) {
            gemm_kloop(acc, br + seg * 512, BR, W + seg * 512, BR, pm * 256, pn * 256, 512 / 64, lds);
            __syncthreads();
            TileIdx t = tile_idx();
#pragma unroll
            for (int ai = 0; ai < 2; ++ai)
#pragma unroll
                for (int m = 0; m < 4; ++m) {
                    int row = pm * 256 + ai * 128 + t.wr * 64 + m * 16 + t.fr;
#pragma unroll
                    for (int bj = 0; bj < 2; ++bj)
#pragma unroll
                        for (int n = 0; n < 2; ++n) {
                            int col = pn * 256 + bj * 128 + t.wc * 32 + n * 16 + t.fq * 4;
                            const bf16_t* gp = g + (size_t)row * NG + col;
                            u32x2 gc = *(const u32x2*)(gp + seg * DM);
                            float c0 = lo_bf(gc[0]), c1 = hi_bf(gc[0]), c2 = lo_bf(gc[1]), c3 = hi_bf(gc[1]);
                            if (seg < 2) {
                                u32x2 gn = *(const u32x2*)(gp + (seg + 1) * DM);
                                c0 = c0 / fmaxf(lo_bf(gn[0]), 1e-30f); c1 = c1 / fmaxf(hi_bf(gn[0]), 1e-30f);
                                c2 = c2 / fmaxf(lo_bf(gn[1]), 1e-30f); c3 = c3 / fmaxf(hi_bf(gn[1]), 1e-30f);
                                acc[ai][bj][m][n][0] *= c0; acc[ai][bj][m][n][1] *= c1; acc[ai][bj][m][n][2] *= c2; acc[ai][bj][m][n][3] *= c3;
                            } else {
                                u32x2 o; o[0] = cvt_pk(acc[ai][bj][m][n][0] * c0, acc[ai][bj][m][n][1] * c1); o[1] = cvt_pk(acc[ai][bj][m][n][2] * c2, acc[ai][bj][m][n][3] * c3);
                                *(u32x2*)(mg + (size_t)row * DM + col) = o;
                            }
                        }
                    __builtin_amdgcn_sched_barrier(0);
                }
        }
        __syncthreads();
    }
}

__device__ __forceinline__ void phase_post1(const Ctx& a, int l, LAS unsigned char* lds) {
    bf16_t* pa = (bf16_t*)(a.ws + B_PROJ); float* rq = (float*)(a.ws + WS_RQ); float* rkv = (float*)(a.ws + WS_RKV);
    const float2* t64 = (const float2*)(a.ws + WS_TAB64);
    const float* gq = a.in(I_MQN) + l * 64; const float* gk = a.in(I_MKN) + l * 64;
    const int lane = fresh_tid() & 63, wv = fresh_tid() >> 6;
    for (int tk = fresh_bid() * 8 + wv; tk < SEQ; tk += gridDim.x * 8) {
        bf16_t* pr = pa + (size_t)tk * PA;
        u32x2 cq = *(const u32x2*)(pr + C_CQ + lane * 4);
        float s1 = lo_bf(cq[0]) * lo_bf(cq[0]) + hi_bf(cq[0]) * hi_bf(cq[0]) + lo_bf(cq[1]) * lo_bf(cq[1]) + hi_bf(cq[1]) * hi_bf(cq[1]);
        unsigned ck = *(const unsigned*)(pr + C_CKV + lane * 2);
        float s2 = lo_bf(ck) * lo_bf(ck) + hi_bf(ck) * hi_bf(ck);
        s1 = wave_sum(s1); s2 = wave_sum(s2);
        if (lane == 0) { rq[tk] = rsqrtf(s1 * (1.f / 256.f) + EPS); rkv[tk] = rsqrtf(s2 * (1.f / 128.f) + EPS); }
        const int i = lane & 31;
        const float2 cs = t64[tk * 32 + i];
        bf16_t xa[8], xb2[8];
#pragma unroll
        for (int jj = 0; jj < 8; ++jj) { const bf16_t* p = pr + C_MQ + ((lane >> 5) + 2 * jj) * 64; xa[jj] = p[i]; xb2[jj] = p[i + 32]; }
#pragma unroll
        for (int jj = 0; jj < 8; ++jj) {
            int vec = (lane >> 5) + 2 * jj;
            bf16_t* p = pr + C_MQ + vec * 64;
            float x1 = bf2f(xa[jj]), x2 = bf2f(xb2[jj]);
            float ss = x1 * x1 + x2 * x2;
#pragma unroll
            for (int o = 16; o > 0; o >>= 1) ss += __shfl_xor(ss, o);
            float r = rsqrtf(ss * (1.f / 64.f) + EPS);
            const float* g = (vec < 8) ? gq : gk;
            float y1 = x1 * r * g[i], y2 = x2 * r * g[i + 32];
            float o1 = y1 * cs.x - y2 * cs.y, o2 = y2 * cs.x + y1 * cs.y;
            if (vec < 8) { o1 *= 0.125f * LOG2E; o2 *= 0.125f * LOG2E; }
            p[i] = f2bf(o1); p[i + 32] = f2bf(o2);
        }
    }
}

__device__ __forceinline__ void phase_post2(const Ctx& a, int l, LAS unsigned char* lds) {
    bf16_t* mr = (bf16_t*)(a.ws + B_MLA); const bf16_t* pa = (const bf16_t*)(a.ws + B_PROJ); bf16_t* kro = (bf16_t*)(a.ws + B_KROPE);
    const float2* t32 = (const float2*)(a.ws + WS_TAB32);
    const float* gq = a.in(I_QN) + l * 96; const float* gk = a.in(I_KN) + l * 96;
    const int lane = fresh_tid() & 63, wv = fresh_tid() >> 6, h = lane >> 3, j = lane & 7;
    const float QS = 0.10206207261596575f * LOG2E;
    for (int tk = fresh_bid() * 8 + wv; tk < SEQ; tk += gridDim.x * 8) {
        const float2 cs0 = t32[tk * 16 + 2 * j], cs1 = t32[tk * 16 + 2 * j + 1];
        const u32x4 nvk = *(const u32x4*)(mr + (size_t)tk * MR + 768 + h * 128 + j * 8);
        const unsigned avk = *(const unsigned*)(pa + (size_t)tk * PA + C_KR + 2 * j), bvk = *(const unsigned*)(pa + (size_t)tk * PA + C_KR + 16 + 2 * j);
        {
            bf16_t* q = mr + (size_t)tk * MR + h * 96;
            u32x4 nv = *(const u32x4*)(q + j * 8);
            unsigned av = *(const unsigned*)(q + 64 + 2 * j), bv = *(const unsigned*)(q + 80 + 2 * j);
            float x[8]; x[0] = lo_bf(nv[0]); x[1] = hi_bf(nv[0]); x[2] = lo_bf(nv[1]); x[3] = hi_bf(nv[1]); x[4] = lo_bf(nv[2]); x[5] = hi_bf(nv[2]); x[6] = lo_bf(nv[3]); x[7] = hi_bf(nv[3]);
            float a0 = lo_bf(av), a1 = hi_bf(av), b0 = lo_bf(bv), b1 = hi_bf(bv);
            float ss = a0 * a0 + a1 * a1 + b0 * b0 + b1 * b1;
#pragma unroll
            for (int e = 0; e < 8; ++e) ss += x[e] * x[e];
            ss += __shfl_xor(ss, 1); ss += __shfl_xor(ss, 2); ss += __shfl_xor(ss, 4);
            float r = rsqrtf(ss * (1.f / 96.f) + EPS) * QS;
#pragma unroll
            for (int e = 0; e < 8; ++e) x[e] *= r * gq[j * 8 + e];
            float ya0 = a0 * r * gq[64 + 2 * j], ya1 = a1 * r * gq[65 + 2 * j], yb0 = b0 * r * gq[80 + 2 * j], yb1 = b1 * r * gq[81 + 2 * j];
            float oa0 = ya0 * cs0.x - yb0 * cs0.y, ob0 = yb0 * cs0.x + ya0 * cs0.y;
            float oa1 = ya1 * cs1.x - yb1 * cs1.y, ob1 = yb1 * cs1.x + ya1 * cs1.y;
            u32x4 w; w[0] = cvt_pk(x[0], x[1]); w[1] = cvt_pk(x[2], x[3]); w[2] = cvt_pk(x[4], x[5]); w[3] = cvt_pk(x[6], x[7]);
            *(u32x4*)(q + j * 8) = w;
            *(unsigned*)(q + 64 + 2 * j) = cvt_pk(oa0, oa1);
            *(unsigned*)(q + 80 + 2 * j) = cvt_pk(ob0, ob1);
        }
        {
            bf16_t* k = mr + (size_t)tk * MR + 768 + h * 128;
            const bf16_t* kr = pa + (size_t)tk * PA + C_KR;
            const u32x4 nv = nvk; const unsigned av = avk, bv = bvk;
            float x[8]; x[0] = lo_bf(nv[0]); x[1] = hi_bf(nv[0]); x[2] = lo_bf(nv[1]); x[3] = hi_bf(nv[1]); x[4] = lo_bf(nv[2]); x[5] = hi_bf(nv[2]); x[6] = lo_bf(nv[3]); x[7] = hi_bf(nv[3]);
            float a0 = lo_bf(av), a1 = hi_bf(av), b0 = lo_bf(bv), b1 = hi_bf(bv);
            float ss = a0 * a0 + a1 * a1 + b0 * b0 + b1 * b1;
#pragma unroll
            for (int e = 0; e < 8; ++e) ss += x[e] * x[e];
            ss += __shfl_xor(ss, 1); ss += __shfl_xor(ss, 2); ss += __shfl_xor(ss, 4);
            float r = rsqrtf(ss * (1.f / 96.f) + EPS);
#pragma unroll
            for (int e = 0; e < 8; ++e) x[e] *= r * gk[j * 8 + e];
            float ya0 = a0 * r * gk[64 + 2 * j], ya1 = a1 * r * gk[65 + 2 * j], yb0 = b0 * r * gk[80 + 2 * j], yb1 = b1 * r * gk[81 + 2 * j];
            float oa0 = ya0 * cs0.x - yb0 * cs0.y, ob0 = yb0 * cs0.x + ya0 * cs0.y;
            float oa1 = ya1 * cs1.x - yb1 * cs1.y, ob1 = yb1 * cs1.x + ya1 * cs1.y;
            u32x4 w; w[0] = cvt_pk(x[0], x[1]); w[1] = cvt_pk(x[2], x[3]); w[2] = cvt_pk(x[4], x[5]); w[3] = cvt_pk(x[6], x[7]);
            *(u32x4*)(k + j * 8) = w;
            bf16_t* ko = kro + ((size_t)tk * 8 + h) * 32;
            *(unsigned*)(ko + 2 * j) = cvt_pk(oa0, oa1);
            *(unsigned*)(ko + 16 + 2 * j) = cvt_pk(ob0, ob1);
        }
    }
}

__device__ __forceinline__ void kmean_items(const Ctx& a, LAS unsigned char* lds) {
    const bf16_t* pa = (const bf16_t*)(a.ws + B_PROJ);
    float* kmean = (float*)(a.ws + WS_KMEAN);
    LAS float* part = (LAS float*)lds;
    for (int it = fresh_bid(); it < 256; it += gridDim.x) {
        int hh = it >> 5, n = it & 31, d = fresh_tid() & 63, tg = fresh_tid() >> 6;
        float s = 0.f;
        bf16_t kx[32];
#pragma unroll
        for (int i = 0; i < 32; ++i) kx[i] = pa[(size_t)(n * 256 + tg * 32 + i) * PA + C_MK + hh * 64 + d];
#pragma unroll
        for (int i = 0; i < 32; ++i) s += bf2f(kx[i]);
        part[tg * 64 + d] = s;
        __syncthreads();
        if (fresh_tid() < 64) {
            float tsum = 0.f;
#pragma unroll
            for (int g2 = 0; g2 < 8; ++g2) tsum += part[g2 * 64 + d];
            kmean[(size_t)it * 64 + d] = tsum * (1.f / 256.f);
        }
        __syncthreads();
    }
}

__device__ __forceinline__ void moba_gate_item(const Ctx& a, int tb, LAS unsigned char* lds) {
    const bf16_t* pa = (const bf16_t*)(a.ws + B_PROJ); const float* kmean = (const float*)(a.ws + WS_KMEAN); unsigned* mask = (unsigned*)(a.ws + WS_MASK);
    const int tid = fresh_tid();
    const int tok = tid & 63, h = __builtin_amdgcn_readfirstlane(tid >> 6), tk = tb * 64 + tok, qb = tk >> 8;
    LAS float* kml = (LAS float*)lds;
    for (int e = tid; e < 8 * qb * 16; e += NT) { const int hh = e / (qb * 16), r = e % (qb * 16); *(LAS f32x4*)(kml + hh * 2048 + r * 4) = *(const f32x4*)(kmean + (size_t)hh * 2048 + r * 4); }
    float q[64];
    const bf16_t* qp = pa + (size_t)tk * PA + C_MQ + h * 64;
#pragma unroll
    for (int c = 0; c < 8; ++c) {
        u32x4 v = *(const u32x4*)(qp + c * 8);
#pragma unroll
        for (int e = 0; e < 4; ++e) { q[c * 8 + 2 * e] = lo_bf(v[e]); q[c * 8 + 2 * e + 1] = hi_bf(v[e]); }
    }
    __syncthreads();
    float v1 = -3e38f, v2 = -3e38f, v3 = -3e38f; int i1 = -1, i2 = -1, i3 = -1;
    for (int n = 0; n < qb; ++n) {
        const LAS float* km = kml + h * 2048 + n * 64;
        float s = 0.f;
#pragma unroll
        for (int d4 = 0; d4 < 16; ++d4) { f32x4 kv = *(const LAS f32x4*)(km + d4 * 4); s += q[d4 * 4] * kv[0] + q[d4 * 4 + 1] * kv[1] + q[d4 * 4 + 2] * kv[2] + q[d4 * 4 + 3] * kv[3]; }
        if (s > v1) { v3 = v2; i3 = i2; v2 = v1; i2 = i1; v1 = s; i1 = n; }
        else if (s > v2) { v3 = v2; i3 = i2; v2 = s; i2 = n; }
        else if (s > v3) { v3 = s; i3 = n; }
    }
    unsigned m = 1u << qb;
    if (i1 >= 0) m |= 1u << i1;
    if (i2 >= 0) m |= 1u << i2;
    if (i3 >= 0) m |= 1u << i3;
    mask[(size_t)h * SEQ + tk] = m;
    __syncthreads();
}

constexpr int GI_QB = 0, GI_KB = 17408, GI_VF = 34816, GI_AM = 34816 + 65536, GI_SM = GI_AM + 17408;
__device__ __forceinline__ void gdn_intra_item(const Ctx& a, int l, int h, int c, LAS unsigned char* lds) {
    const bf16_t* pa = (const bf16_t*)(a.ws + B_PROJ);
    LAS bf16_t* qb = (LAS bf16_t*)(lds + GI_QB); LAS bf16_t* kb = (LAS bf16_t*)(lds + GI_KB);
    LAS float* vf = (LAS float*)(lds + GI_VF);
    LAS float* Am = (LAS float*)(lds + GI_AM);
    LAS float* sm = (LAS float*)(lds + GI_SM);
    LAS float* gc = sm; LAS float* be = sm + 64; LAS float* sq = sm + 128; LAS float* sk = sm + 256; LAS float* rqv = sm + 384; LAS float* rkv = sm + 448; LAS float* eg = sm + 512;
    const int tid = fresh_tid(), lane = tid & 63, wv = tid >> 6;
    const int t0 = c * 64;
    if (wv == 0) {
        const bf16_t* pr = pa + (size_t)(t0 + lane) * PA;
        float al = bf2f(pr[C_GA + h]) + a.in(I_DTB)[l * 4 + h];
        float sp = fmaxf(al, 0.f) + __logf(1.f + __expf(-fabsf(al)));
        float g = -__expf(a.in(I_ALOG)[l * 4 + h]) * sp;
        float bt = sigmoidf_(bf2f(pr[C_GB + h]));
#pragma unroll
        for (int o = 1; o < 64; o <<= 1) { float u = __shfl_up(g, o); if (lane >= o) g += u; }
        gc[lane] = g; be[lane] = bt; eg[lane] = __expf(g);
    }
    {
        const int d = tid & 127, rg = tid >> 7;
        const float* cw = a.in(I_CONV) + (size_t)l * 4 * 1536;
        const int ts = t0 + rg * 16;
        bf16_t xr[3][19];
#pragma unroll
        for (int part = 0; part < 3; ++part) {
            const bf16_t* src = pa + C_GQ + part * 512 + h * 128 + d;
#pragma unroll
            for (int i = 0; i < 19; ++i) { const int tt = ts - 3 + i; xr[part][i] = src[(size_t)(tt < 0 ? 0 : tt) * PA]; }
        }
        float wq[3][4];
#pragma unroll
        for (int part = 0; part < 3; ++part)
#pragma unroll
            for (int j = 0; j < 4; ++j) wq[part][j] = cw[j * 1536 + part * 512 + h * 128 + d];
#pragma unroll
        for (int part = 0; part < 3; ++part) {
#pragma unroll
            for (int i = 0; i < 16; ++i) {
                float x0 = (ts - 3 + i >= 0) ? bf2f(xr[part][i]) : 0.f, x1 = (ts - 2 + i >= 0) ? bf2f(xr[part][i + 1]) : 0.f, x2 = (ts - 1 + i >= 0) ? bf2f(xr[part][i + 2]) : 0.f;
                float y = wq[part][0] * x0 + wq[part][1] * x1 + wq[part][2] * x2 + wq[part][3] * bf2f(xr[part][i + 3]);
                y = siluf_(y);
                const int r = rg * 16 + i;
                if (part == 2) vf[r * 256 + d] = y;
                else if (part == 0) qb[r * 136 + d] = f2bf(y);
                else kb[r * 136 + d] = f2bf(y);
            }
        }
    }
    __syncthreads();
    {
        const int row = tid >> 3, part = tid & 7;
        float s1 = 0.f, s2 = 0.f;
#pragma unroll
        for (int c = 0; c < 2; ++c) {
            u32x4 qv = *(const LAS u32x4*)(qb + row * 136 + part * 16 + c * 8), kv = *(const LAS u32x4*)(kb + row * 136 + part * 16 + c * 8);
#pragma unroll
            for (int e = 0; e < 4; ++e) { float a0 = lo_bf(qv[e]), a1 = hi_bf(qv[e]), b0 = lo_bf(kv[e]), b1 = hi_bf(kv[e]); s1 += a0 * a0 + a1 * a1; s2 += b0 * b0 + b1 * b1; }
        }
        s1 += __shfl_xor(s1, 1); s1 += __shfl_xor(s1, 2); s1 += __shfl_xor(s1, 4);
        s2 += __shfl_xor(s2, 1); s2 += __shfl_xor(s2, 2); s2 += __shfl_xor(s2, 4);
        if (part == 0) { rqv[row] = rsqrtf(s1 + EPS) * 0.08838834764831845f; rkv[row] = rsqrtf(s2 + EPS); }
    }
    __syncthreads();
    {
        const int type = wv >> 2, blk = wv & 3, bi = blk >> 1, bj = blk & 1, l32 = lane & 31, hb = lane >> 5;
        LAS bf16_t* X = type ? qb : kb;
        f32x16 acc;
#pragma unroll
        for (int r = 0; r < 16; ++r) acc[r] = 0.f;
#pragma unroll
        for (int kk = 0; kk < 8; ++kk) {
            bf16x8 av = *(const LAS bf16x8*)(X + (bi * 32 + l32) * 136 + kk * 16 + hb * 8);
            bf16x8 bv = *(const LAS bf16x8*)(kb + (bj * 32 + l32) * 136 + kk * 16 + hb * 8);
            acc = __builtin_amdgcn_mfma_f32_32x32x16_bf16(av, bv, acc, 0, 0, 0);
        }
        const int jcol = bj * 32 + l32;
        const float gj = gc[jcol], rkj = rkv[jcol];
        bf16_t* qkg = (bf16_t*)(a.ws + B_GQK) + ((size_t)(h * 128 + c) * 64) * 64;
#pragma unroll
        for (int r = 0; r < 16; ++r) {
            int i = bi * 32 + (r >> 2) * 8 + hb * 4 + (r & 3);
            float dec = __expf(fminf(gc[i] - gj, 0.f));
            if (type == 0) { float v = (jcol < i) ? acc[r] * rkv[i] * rkj * be[i] * dec : 0.f; Am[i * 68 + jcol] = v; }
            else { float v = (jcol <= i) ? acc[r] * rqv[i] * rkj * dec : 0.f; qkg[(size_t)i * 64 + jcol] = f2bf(v); }
        }
    }
    __syncthreads();
    if (tid < 256) {
        const int cc = tid, d = cc & 127;
        LAS float* xc = vf + cc;
        bf16_t* dst = (bf16_t*)(a.ws + B_GW) + (size_t)t0 * 512 + h * 128 + d;
        bf16_t* dstu = (bf16_t*)(a.ws + B_GU) + ((size_t)((h * 128 + c) * 4 + (d >> 5)) * 2) * 1024 + (d & 31) * 16;
#pragma unroll 1
        for (int bs = 0; bs < 64; bs += 16) {
            float acc[16];
            if (cc < 128) {
#pragma unroll
                for (int r = 0; r < 16; ++r) { const int i = bs + r; acc[r] = xc[i * 256] * be[i]; }
            } else {
#pragma unroll
                for (int r = 0; r < 16; ++r) { const int i = bs + r; acc[r] = bf2f(kb[i * 136 + d]) * rkv[i] * be[i] * eg[i]; }
            }
#pragma unroll 1
            for (int j = 0; j < bs; j += 4) {
                const float x0 = xc[(j + 0) * 256], x1 = xc[(j + 1) * 256], x2 = xc[(j + 2) * 256], x3 = xc[(j + 3) * 256];
#pragma unroll
                for (int r = 0; r < 16; ++r) {
                    f32x4 av = *(const LAS f32x4*)(Am + (bs + r) * 68 + j);
                    acc[r] -= av[0] * x0 + av[1] * x1 + av[2] * x2 + av[3] * x3;
                }
            }
#pragma unroll
            for (int r = 0; r < 16; ++r) {
#pragma unroll
                for (int c4 = 0; c4 < (r + 3) / 4; ++c4) {
                    f32x4 av = *(const LAS f32x4*)(Am + (bs + r) * 68 + bs + c4 * 4);
#pragma unroll
                    for (int e = 0; e < 4; ++e) if (c4 * 4 + e < r) acc[r] -= av[e] * acc[c4 * 4 + e];
                }
                const int i = bs + r;
                xc[i * 256] = acc[r];
                { const int i32 = i & 31; const int offu = (i >> 5) * 1024 + ((i32 >> 2) & 1) * 512 + (i32 >> 3) * 4 + (i & 3);
                  bf16_t* ob = (cc < 128) ? dstu : dst; ob[(cc < 128) ? offu : i * 512] = f2bf(acc[r]); }
            }
        }
    } else {
        const int u = tid - 256, d = u & 127, hf = u >> 7;
        bf16_t* qd = (bf16_t*)(a.ws + B_GQD) + (size_t)t0 * 512 + h * 128 + d;
        bf16_t* kt = (bf16_t*)(a.ws + B_GKT) + ((size_t)(h * 128 + c) * 128 + d) * 64 + hf * 32;
        const float gl = gc[63];
#pragma unroll
        for (int i4 = 0; i4 < 4; ++i4) {
            float kv[8];
#pragma unroll
            for (int e = 0; e < 8; ++e) {
                int i = hf * 32 + i4 * 8 + e;
                qd[(size_t)i * 512] = f2bf(bf2f(qb[i * 136 + d]) * rqv[i] * eg[i]);
                kv[e] = bf2f(kb[i * 136 + d]) * rkv[i] * __expf(gl - gc[i]);
            }
            u32x4 w; w[0] = cvt_pk(kv[0], kv[1]); w[1] = cvt_pk(kv[2], kv[3]); w[2] = cvt_pk(kv[4], kv[5]); w[3] = cvt_pk(kv[6], kv[7]);
            *(u32x4*)(kt + i4 * 8) = w;
        }
        if (u == 0) ((float*)(a.ws + WS_GLAST))[h * 128 + c] = gl;
    }
    __syncthreads();
}

__device__ __forceinline__ void phase_prep(const Ctx& a, int l, LAS unsigned char* lds) {
    for (int it = fresh_bid(); it < 512 + 128; it += gridDim.x) {
        if (it < 512) gdn_intra_item(a, l, it & 3, it >> 2, lds);
        else moba_gate_item(a, it - 512, lds);
    }
}

constexpr int GS_W = 0, GS_Q = 16896, GS_K = 33792, GS_QK = 51200, GS_BUF = 59904, GS_O = 2 * GS_BUF;
__device__ __forceinline__ bf16x8 lds_a2(const LAS bf16_t* p) {
    u32x2 lo = *(const LAS u32x2*)p, hi = *(const LAS u32x2*)(p + 8);
    u32x4 v; v[0] = lo[0]; v[1] = lo[1]; v[2] = hi[0]; v[3] = hi[1];
    return __builtin_bit_cast(bf16x8, v);
}
__device__ __forceinline__ bf16x8 pack8(const f32x16& v, int c) {
    u32x4 w; w[0] = cvt_pk(v[c * 8 + 0], v[c * 8 + 1]); w[1] = cvt_pk(v[c * 8 + 2], v[c * 8 + 3]); w[2] = cvt_pk(v[c * 8 + 4], v[c * 8 + 5]); w[3] = cvt_pk(v[c * 8 + 6], v[c * 8 + 7]);
    return __builtin_bit_cast(bf16x8, w);
}
__device__ __forceinline__ void gdn_scan_item(const Ctx& a, int l, int b, int h, int half, LAS unsigned char* lds, int variant) {
    const int tid = fresh_tid(), lane = tid & 63, wv = tid >> 6, l32 = lane & 31, hb = lane >> 5;
    const bf16_t* gu = (const bf16_t*)(a.ws + B_GU); const bf16_t* gw = (const bf16_t*)(a.ws + B_GW); const bf16_t* gqd = (const bf16_t*)(a.ws + B_GQD);
    const bf16_t* gkt = (const bf16_t*)(a.ws + B_GKT); const bf16_t* gqk = (const bf16_t*)(a.ws + B_GQK); const float* glast = (const float*)(a.ws + WS_GLAST);
    const bf16_t* pa = (const bf16_t*)(a.ws + B_PROJ); bf16_t* br = (bf16_t*)(a.ws + B_BRANCH);
    const bool loader = wv >= 4;
    const int u = tid - 256;
    u32x4 pfA[14], pfB[14];
    const unsigned offWQ = (unsigned)(((u >> 4) * 512 + (u & 15) * 8) * 2), offKT = (unsigned)(((u >> 3) * 64 + (u & 7) * 8) * 2);
#define GS_LOAD(n, pf) do { const char* w_ = (const char*)(gw + (size_t)((n) * 64) * 512 + h * 128); const char* q_b = (const char*)(gqd + (size_t)((n) * 64) * 512 + h * 128); \
    const char* k_ = (const char*)(gkt + (size_t)(h * 128 + (n)) * 128 * 64); const char* qk_ = (const char*)(gqk + (size_t)(h * 128 + (n)) * 64 * 64); \
    _Pragma("unroll") for (int q_ = 0; q_ < 4; ++q_) pf[q_] = *(const u32x4*)(w_ + q_ * 16 * 512 * 2 + offWQ); \
    _Pragma("unroll") for (int q_ = 0; q_ < 4; ++q_) pf[4 + q_] = *(const u32x4*)(q_b + q_ * 16 * 512 * 2 + offWQ); \
    _Pragma("unroll") for (int q_ = 0; q_ < 4; ++q_) pf[8 + q_] = *(const u32x4*)(k_ + q_ * 32 * 64 * 2 + offKT); \
    _Pragma("unroll") for (int q_ = 0; q_ < 2; ++q_) pf[12 + q_] = *(const u32x4*)(qk_ + q_ * 32 * 64 * 2 + offKT); } while (0)
#define GS_ST8(p, v) do { LAS u32x2* p_ = (LAS u32x2*)(p); u32x2 a_; a_[0] = (v)[0]; a_[1] = (v)[1]; u32x2 b_; b_[0] = (v)[2]; b_[1] = (v)[3]; p_[0] = a_; p_[1] = b_; } while (0)
#define GS_STORE(bufi, pf) do { LAS unsigned char* B_ = lds + (bufi) * GS_BUF; \
    _Pragma("unroll") for (int q_ = 0; q_ < 4; ++q_) { int ch = u + q_ * 256; GS_ST8(B_ + GS_W + (ch >> 4) * 264 + (ch & 15) * 16, pf[q_]); } \
    _Pragma("unroll") for (int q_ = 0; q_ < 4; ++q_) { int ch = u + q_ * 256; GS_ST8(B_ + GS_Q + (ch >> 4) * 264 + (ch & 15) * 16, pf[4 + q_]); } \
    _Pragma("unroll") for (int q_ = 0; q_ < 4; ++q_) { int ch = u + q_ * 256; GS_ST8(B_ + GS_K + (ch >> 3) * 136 + (ch & 7) * 16, pf[8 + q_]); } \
    _Pragma("unroll") for (int q_ = 0; q_ < 2; ++q_) { int ch = u + q_ * 256; GS_ST8(B_ + GS_QK + (ch >> 3) * 136 + (ch & 7) * 16, pf[12 + q_]); } } while (0)
#define GS_BAR() asm volatile("s_waitcnt lgkmcnt(0)\n\ts_barrier" ::: "memory")
    f32x16 S[4];
#pragma unroll
    for (int kb = 0; kb < 4; ++kb)
#pragma unroll
        for (int r = 0; r < 16; ++r) S[kb][r] = 0.f;
    const int dv0 = half * 32;
    u32x4 U[2][2]; float gl_next = 0.f;
#define GS_LOADU(n) do { const bf16_t* up_ = gu + ((size_t)((h * 128 + (n)) * 4 + half) * 2) * 1024 + lane * 16; \
    _Pragma("unroll") for (int tb_ = 0; tb_ < 2; ++tb_) { U[tb_][0] = *(const u32x4*)(up_ + tb_ * 1024); U[tb_][1] = *(const u32x4*)(up_ + tb_ * 1024 + 8); } \
    gl_next = __expf(glast[h * 128 + (n)]); } while (0)

    if (loader) { GS_LOAD(0, pfA); GS_STORE(0, pfA); GS_LOAD(1, pfB); } else if (wv < 1) { GS_LOADU(0); }
    __syncthreads();
    if (loader) {
        for (int n = 0; n < 128; n += 2) {
            const int c2 = (n + 2 < 128) ? n + 2 : 127, c3 = (n + 3 < 128) ? n + 3 : 127;
            if (variant != 1) { GS_LOAD(c2, pfA); GS_STORE(1, pfB); }
            GS_BAR();
            if (variant != 1) { GS_LOAD(c3, pfB); GS_STORE(0, pfA); }
            GS_BAR();
        }
    } else if (wv >= 1) {
        for (int n = 0; n < 128; ++n) GS_BAR();
    } else {
        __builtin_amdgcn_s_setprio(3);
        for (int n = 0; n < 128; ++n) {
            const int bufi = n & 1;
            if (variant == 2) { GS_BAR(); continue; }
            LAS unsigned char* Bf = lds + bufi * GS_BUF;
            const LAS bf16_t* Wb = (const LAS bf16_t*)(Bf + GS_W); const LAS bf16_t* Qb = (const LAS bf16_t*)(Bf + GS_Q);
            const LAS bf16_t* Kt = (const LAS bf16_t*)(Bf + GS_K); const LAS bf16_t* QKb = (const LAS bf16_t*)(Bf + GS_QK);
            f32x16 vn[2], o[2];
            const float gl = gl_next;
#pragma unroll
            for (int tb = 0; tb < 2; ++tb)
#pragma unroll
                for (int r = 0; r < 16; ++r) { vn[tb][r] = 0.f; o[tb][r] = 0.f; }
            bf16x8 aop[16];
#pragma unroll
            for (int kb = 0; kb < 4; ++kb) {
#pragma unroll
                for (int c = 0; c < 2; ++c)
#pragma unroll
                    for (int tb = 0; tb < 2; ++tb) {
                        aop[c * 2 + tb] = lds_a2(Wb + (tb * 32 + l32) * 132 + kb * 32 + c * 16 + hb * 4);
                        aop[4 + c * 2 + tb] = lds_a2(Qb + (tb * 32 + l32) * 132 + kb * 32 + c * 16 + hb * 4);
                    }
                __builtin_amdgcn_sched_barrier(0);
#pragma unroll
                for (int c = 0; c < 2; ++c) {
                    bf16x8 sb = pack8(S[kb], c);
#pragma unroll
                    for (int tb = 0; tb < 2; ++tb) {
                        vn[tb] = __builtin_amdgcn_mfma_f32_32x32x16_bf16(aop[c * 2 + tb], sb, vn[tb], 0, 0, 0);
                        o[tb] = __builtin_amdgcn_mfma_f32_32x32x16_bf16(aop[4 + c * 2 + tb], sb, o[tb], 0, 0, 0);
                    }
                }
                __builtin_amdgcn_sched_barrier(0);
            }
            bf16x8 vb[2][2];
#pragma unroll
            for (int tb = 0; tb < 2; ++tb) {
#pragma unroll
                for (int r = 0; r < 16; ++r) { unsigned uw = U[tb][r >> 3][(r >> 1) & 3]; vn[tb][r] = ((r & 1) ? hi_bf(uw) : lo_bf(uw)) - vn[tb][r]; }
                vb[tb][0] = pack8(vn[tb], 0); vb[tb][1] = pack8(vn[tb], 1);
            }
            __builtin_amdgcn_sched_barrier(0);
            { const int n1_ = (n + 1 < 128) ? n + 1 : 127; GS_LOADU(n1_); }
            bf16x8 qop[8];
#pragma unroll
            for (int kb = 0; kb < 4; ++kb)
#pragma unroll
                for (int tb2 = 0; tb2 < 2; ++tb2)
#pragma unroll
                    for (int c = 0; c < 2; ++c) aop[(kb * 2 + tb2) * 2 + c] = lds_a2(Kt + (kb * 32 + l32) * 68 + tb2 * 32 + c * 16 + hb * 4);
#pragma unroll
            for (int kb = 0; kb < 4; ++kb)
#pragma unroll
                for (int r = 0; r < 16; ++r) S[kb][r] *= gl;
            __builtin_amdgcn_sched_barrier(0);
#pragma unroll
            for (int tb2 = 0; tb2 < 2; ++tb2)
#pragma unroll
                for (int c = 0; c < 2; ++c)
#pragma unroll
                    for (int kb = 0; kb < 4; ++kb)
                        S[kb] = __builtin_amdgcn_mfma_f32_32x32x16_bf16(aop[(kb * 2 + tb2) * 2 + c], vb[tb2][c], S[kb], 0, 0, 0);
            __builtin_amdgcn_sched_barrier(0);
#pragma unroll
            for (int tb2 = 0; tb2 < 2; ++tb2)
#pragma unroll
                for (int c = 0; c < 2; ++c)
#pragma unroll
                    for (int tb = 0; tb < 2; ++tb) qop[(tb2 * 2 + c) * 2 + tb] = lds_a2(QKb + (tb * 32 + l32) * 68 + tb2 * 32 + c * 16 + hb * 4);
            __builtin_amdgcn_sched_barrier(0);
#pragma unroll
            for (int tb2 = 0; tb2 < 2; ++tb2)
#pragma unroll
                for (int c = 0; c < 2; ++c)
#pragma unroll
                    for (int tb = 0; tb < 2; ++tb) o[tb] = __builtin_amdgcn_mfma_f32_32x32x16_bf16(qop[(tb2 * 2 + c) * 2 + tb], vb[tb2][c], o[tb], 0, 0, 0);
            __builtin_amdgcn_sched_barrier(0);
            {
                bf16_t* op = br + ((size_t)b * SEQ + n * 64) * BR + 512 + h * 128 + dv0 + l32;
#pragma unroll
                for (int tb = 0; tb < 2; ++tb)
#pragma unroll
                    for (int r = 0; r < 16; ++r) op[(size_t)(tb * 32 + (r >> 2) * 8 + hb * 4 + (r & 3)) * BR] = f2bf(o[tb][r]);
            }
            GS_BAR();
        }
        __builtin_amdgcn_s_setprio(0);
    }
    __syncthreads();
}

template <int TYPE>
__device__ __forceinline__ void attn_item(const Ctx& a, int b, int h, int qt, LAS unsigned char* lds) {
    constexpr int DK = TYPE == 0 ? 96 : 64, KLD = DK + 8, KBYTES = 128 * KLD * 2, VLD = 132, VBYTES = 64 * VLD * 2, BUF = KBYTES + VBYTES, NKK = DK / 16;
    constexpr int NKC = TYPE == 0 ? 3 : 2;
    const int tid = fresh_tid(), lane = tid & 63, wv = tid >> 6, l32 = lane & 31, hb = lane >> 5;
    const bf16_t* mr = (const bf16_t*)(a.ws + B_MLA); const bf16_t* pa = (const bf16_t*)(a.ws + B_PROJ); const bf16_t* kro = (const bf16_t*)(a.ws + B_KROPE);
    bf16_t* br = (bf16_t*)(a.ws + B_BRANCH);
    const int qrow = qt * 256 + wv * 32 + l32;
    bf16x8 Q[NKK];
    {
        const bf16_t* qp = TYPE == 0 ? mr + (size_t)qrow * MR + h * 96 : pa + (size_t)qrow * PA + C_MQ + h * 64;
#pragma unroll
        for (int kk = 0; kk < NKK; ++kk) Q[kk] = *(const bf16x8*)(qp + kk * 16 + hb * 8);
    }
    unsigned qmask = 0xffffffffu;
    if (TYPE == 1) qmask = ((const unsigned*)(a.ws + WS_MASK))[(size_t)h * SEQ + qrow];
    f32x16 oacc[2];
#pragma unroll
    for (int db = 0; db < 2; ++db)
#pragma unroll
        for (int r = 0; r < 16; ++r) oacc[db][r] = 0.f;
    float mrun = 0.f, lrun = 0.f;
    const int npair = (qt + 1) * 2;
    u32x4 kreg[NKC], vreg[2];
#define AT_LOAD(kp) do { const int k0_ = (kp) * 128; \
    _Pragma("unroll") for (int j_ = 0; j_ < NKC; ++j_) { const int ch = tid + j_ * 512; \
        if (TYPE == 0) { const int row = ch / 12, part = ch % 12; \
            const bf16_t* p_ = part < 8 ? mr + (size_t)(k0_ + row) * MR + 768 + h * 128 + part * 8 : kro + ((size_t)(k0_ + row) * 8 + h) * 32 + (part - 8) * 8; kreg[j_] = *(const u32x4*)p_; } \
        else kreg[j_] = *(const u32x4*)(pa + (size_t)(k0_ + (ch >> 3)) * PA + C_MK + h * 64 + (ch & 7) * 8); } \
    _Pragma("unroll") for (int j_ = 0; j_ < 2; ++j_) { const int ch = tid + j_ * 512, vk = ch >> 3, vc = ch & 7; \
        vreg[j_] = TYPE == 0 ? *(const u32x4*)(mr + (size_t)(k0_ + vk) * MR + 768 + h * 128 + 64 + vc * 8) : *(const u32x4*)(pa + (size_t)(k0_ + vk) * PA + C_MV + h * 64 + vc * 8); } } while (0)
#define AT_STORE(bufi) do { LAS unsigned char* B_ = lds + (bufi) * BUF; \
    _Pragma("unroll") for (int j_ = 0; j_ < NKC; ++j_) { const int ch = tid + j_ * 512; \
        if (TYPE == 0) { const int row = ch / 12, part = ch % 12; *(LAS u32x4*)(B_ + row * (KLD * 2) + part * 16) = kreg[j_]; } \
        else *(LAS u32x4*)(B_ + (ch >> 3) * (KLD * 2) + (ch & 7) * 16) = kreg[j_]; } \
    LAS bf16_t* VT_ = (LAS bf16_t*)(B_ + KBYTES); \
    _Pragma("unroll") for (int j_ = 0; j_ < 2; ++j_) { const int ch = tid + j_ * 512, vk = ch >> 3, vc = ch & 7; \
        _Pragma("unroll") for (int e_ = 0; e_ < 4; ++e_) { VT_[(vc * 8 + 2 * e_) * VLD + vk] = (bf16_t)(vreg[j_][e_] & 0xffffu); VT_[(vc * 8 + 2 * e_ + 1) * VLD + vk] = (bf16_t)(vreg[j_][e_] >> 16); } } } while (0)

    AT_LOAD(0); AT_STORE(0);
    __syncthreads();
    for (int kp = 0; kp < npair; ++kp) {
        const int bufi = kp & 1;
        if (kp + 1 < npair) AT_LOAD(kp + 1);
        LAS unsigned char* Bf = lds + bufi * BUF;
        const LAS bf16_t* Kt = (const LAS bf16_t*)Bf; const LAS bf16_t* VT = (const LAS bf16_t*)(Bf + KBYTES);
        f32x16 s[2][2];
        bool act[2];
        const float mref = mrun;
#pragma unroll
        for (int sub = 0; sub < 2; ++sub) {
            const int kloc = kp * 2 + sub - qt * 4;
            act[sub] = (kloc < 0) || (kloc * 64 <= wv * 32 + 31);
            if (TYPE == 1 && kloc < 0) act[sub] = __builtin_amdgcn_ballot_w64((qmask >> ((kp * 2 + sub) >> 2)) & 1u) != 0ull;
#pragma unroll
            for (int kb = 0; kb < 2; ++kb)
#pragma unroll
                for (int r = 0; r < 16; ++r) s[sub][kb][r] = -mref;
        }
#pragma unroll
        for (int kk = 0; kk < NKK; ++kk)
#pragma unroll
            for (int sub = 0; sub < 2; ++sub)
                if (act[sub]) {
#pragma unroll
                    for (int kb = 0; kb < 2; ++kb) {
                        bf16x8 ka = *(const LAS bf16x8*)(Kt + (sub * 64 + kb * 32 + l32) * KLD + kk * 16 + hb * 8);
                        s[sub][kb] = __builtin_amdgcn_mfma_f32_32x32x16_bf16(ka, Q[kk], s[sub][kb], 0, 0, 0);
                    }
                }
#pragma unroll
        for (int sub = 0; sub < 2; ++sub) {
            if (!act[sub]) continue;
            const int kt = kp * 2 + sub, kloc = kt - qt * 4;
            if (kloc >= 0) {
#pragma unroll
                for (int kb = 0; kb < 2; ++kb)
#pragma unroll
                    for (int r = 0; r < 16; ++r) { int kabs = kt * 64 + kb * 32 + (r >> 2) * 8 + hb * 4 + (r & 3); if (kabs > qrow) s[sub][kb][r] = -1e30f; }
            } else if (TYPE == 1) {
                if (!((qmask >> (kt >> 2)) & 1u)) {
#pragma unroll
                    for (int kb = 0; kb < 2; ++kb)
#pragma unroll
                        for (int r = 0; r < 16; ++r) s[sub][kb][r] = -1e30f;
                }
            }
            float mx = -1e30f;
#pragma unroll
            for (int kb = 0; kb < 2; ++kb)
#pragma unroll
                for (int r = 0; r < 16; ++r) mx = fmaxf(mx, s[sub][kb][r]);
            mx = fmaxf(mx, __shfl_xor(mx, 32));
            const float delta = mrun - mref;
            const bool bump = (mx - delta) > 8.f;
            const bool rare = __builtin_amdgcn_ballot_w64(bump || delta != 0.f) != 0ull;
            float fpost = 1.f;
            if (rare) {
                const float mnew = bump ? mref + mx : mrun;
                const float pre = __builtin_amdgcn_exp2f(delta);
                fpost = __builtin_amdgcn_exp2f(mref - mnew);
                mrun = mnew;
                lrun *= pre;
#pragma unroll
                for (int db = 0; db < 2; ++db)
#pragma unroll
                    for (int r = 0; r < 16; ++r) oacc[db][r] *= pre;
            }
            float ps = 0.f;
#pragma unroll
            for (int kb = 0; kb < 2; ++kb)
#pragma unroll
                for (int r = 0; r < 16; ++r) { float p = __builtin_amdgcn_exp2f(s[sub][kb][r]); s[sub][kb][r] = p; ps += p; }
            lrun += ps;
#pragma unroll
            for (int kb = 0; kb < 2; ++kb)
#pragma unroll
                for (int c = 0; c < 2; ++c) {
                    bf16x8 pb = pack8(s[sub][kb], c);
#pragma unroll
                    for (int db = 0; db < 2; ++db)
                        oacc[db] = __builtin_amdgcn_mfma_f32_32x32x16_bf16(lds_a2(VT + (db * 32 + l32) * VLD + sub * 64 + kb * 32 + c * 16 + hb * 4), pb, oacc[db], 0, 0, 0);
                }
            if (rare) {
                lrun *= fpost;
#pragma unroll
                for (int db = 0; db < 2; ++db)
#pragma unroll
                    for (int r = 0; r < 16; ++r) oacc[db][r] *= fpost;
            }
        }
        if (kp + 1 < npair) AT_STORE(bufi ^ 1);
        __syncthreads();
    }
    lrun += __shfl_xor(lrun, 32);
    const float inv = 1.f / lrun;
    bf16_t* op = br + ((size_t)b * SEQ + qrow) * BR + (TYPE == 0 ? 0 : 1024) + h * 64;
#pragma unroll
    for (int db = 0; db < 2; ++db)
#pragma unroll
        for (int g = 0; g < 4; ++g) {
            u32x2 w; w[0] = cvt_pk(oacc[db][g * 4 + 0] * inv, oacc[db][g * 4 + 1] * inv); w[1] = cvt_pk(oacc[db][g * 4 + 2] * inv, oacc[db][g * 4 + 3] * inv);
            *(u32x2*)(op + db * 32 + g * 8 + hb * 4) = w;
        }
}

__device__ __forceinline__ void phase_mix(const Ctx& a, int l, int b, LAS unsigned char* lds, int rep) {
    unsigned* ctr = (unsigned*)(a.ws + WS_CTR) + ((l * 2 + b) * 2 + rep);
    const bool do_scan = (rep == 0) || REP_MODE != 2, do_attn = (rep == 0) || REP_MODE != 1;
    LAS int* sitem = (LAS int*)(lds + LDS_BYTES - 16);
    if (do_scan && fresh_bid() < 16) gdn_scan_item(a, l, b, fresh_bid() >> 2, fresh_bid() & 3, lds, rep ? SCAN_VARIANT : 0);
    if (do_attn) for (;;) {
        if (fresh_tid() == 0) *sitem = (int)atomicAdd(ctr, 1u);
        __syncthreads();
        const int it = *sitem;
        __syncthreads();
        if (it >= 512) break;
        const int qt = 31 - (it >> 4), sub = it & 15, h = sub & 7;
        if (sub < 8) attn_item<0>(a, b, h, qt, lds); else attn_item<1>(a, b, h, qt, lds);
        __syncthreads();
    }
}

__device__ __forceinline__ void phase_gdnpost(const Ctx& a, int l, int b) {
    const bf16_t* pa = (const bf16_t*)(a.ws + B_PROJ); bf16_t* br = (bf16_t*)(a.ws + B_BRANCH);
    const float* onorm = a.in(I_ONORM) + l * 128;
    const int tid = fresh_tid(), lane = tid & 63, wv = tid >> 6;
    float g[8];
#pragma unroll
    for (int e = 0; e < 8; ++e) g[e] = onorm[(lane & 15) * 8 + e];
    for (int tk = fresh_bid() * 8 + wv; tk < SEQ; tk += gridDim.x * 8) {
        bf16_t* op = br + ((size_t)b * SEQ + tk) * BR + 512 + lane * 8;
        u32x4 ov = *(const u32x4*)op;
        u32x4 zv = *(const u32x4*)(pa + (size_t)tk * PA + C_GZ + lane * 8);
        float x[8]; float ss = 0.f;
#pragma unroll
        for (int e = 0; e < 4; ++e) { x[2 * e] = lo_bf(ov[e]); x[2 * e + 1] = hi_bf(ov[e]); ss += x[2 * e] * x[2 * e] + x[2 * e + 1] * x[2 * e + 1]; }
        ss += __shfl_xor(ss, 1); ss += __shfl_xor(ss, 2); ss += __shfl_xor(ss, 4); ss += __shfl_xor(ss, 8);
        const float r = rsqrtf(ss * (1.f / 128.f) + EPS);
        u32x4 w;
#pragma unroll
        for (int e = 0; e < 4; ++e) w[e] = cvt_pk(x[2 * e] * r * g[2 * e] * siluf_(lo_bf(zv[e])), x[2 * e + 1] * r * g[2 * e + 1] * siluf_(hi_bf(zv[e])));
        *(u32x4*)op = w;
    }
}

#define XB_TMO      128
#define XB_XCNT(j)  (256  + 64 * (j))
#define XB_XSUB(j)  (1280 + 64 * (j))
#define XB_XGEN(j)  (2304 + 64 * (j))
#define XB_TOP      3328
#define XB_TOPGEN   3392
#define XB_SPIN_CAP (1u << 18)
__device__ __forceinline__ unsigned xb_ld(unsigned* p)              { return __hip_atomic_load(p, __ATOMIC_RELAXED, __HIP_MEMORY_SCOPE_AGENT); }
__device__ __forceinline__ unsigned xb_add(unsigned* p, unsigned v) { return __hip_atomic_fetch_add(p, v, __ATOMIC_RELAXED, __HIP_MEMORY_SCOPE_AGENT); }
__device__ __forceinline__ unsigned xb_xcc_id() { return (unsigned)__builtin_amdgcn_s_getreg((3 << 11) | 20) & 0xFu; }
#define XB_SPIN(cond, bar) do { unsigned _sp = 0; while (cond) { __builtin_amdgcn_s_sleep(1); \
    if ((++_sp & 255u) == 0u) { if (xb_ld(&(bar)[XB_TMO])) break; if (_sp > XB_SPIN_CAP) { atomicAdd(&(bar)[XB_TMO], 1u); break; } } } } while (0)
struct XcdBarrier { unsigned* bar; unsigned x; volatile LAS unsigned* st; };
__device__ __forceinline__ XcdBarrier xcd_barrier_post(unsigned* bar, volatile LAS unsigned* st) {
    XcdBarrier b; b.bar = bar; b.x = xb_xcc_id(); b.st = st;
    if (threadIdx.x == 0) (void)xb_add(&bar[XB_XCNT(b.x)], 1u);
    return b;
}
__device__ __forceinline__ void xcd_barrier_complete(unsigned* bar, unsigned x, unsigned& nloc, unsigned& nx) {
    const unsigned G = gridDim.x * gridDim.y * gridDim.z;
    unsigned sum, cnt, mine, sp = 0u;
    for (;;) {
        sum = 0u; cnt = 0u; mine = 0u;
#pragma unroll
        for (unsigned j = 0; j < 16; ++j) { const unsigned c = xb_ld(&bar[XB_XCNT(j)]); sum += c; cnt += (c > 0u) ? 1u : 0u; mine = (j == x) ? c : mine; }
        if (sum == G) break;
        __builtin_amdgcn_s_sleep(1);
        if ((++sp & 255u) == 0u) { if (xb_ld(&bar[XB_TMO])) break; if (sp > XB_SPIN_CAP) { atomicAdd(&bar[XB_TMO], 1u); break; } }
    }
    nloc = mine > 0u ? mine : 1u; nx = cnt > 0u ? cnt : 1u;
}
__device__ __forceinline__ void xcd_barrier(const XcdBarrier& b) {
    asm volatile("s_waitcnt vmcnt(0)" ::: "memory");
    __syncthreads();
    if (threadIdx.x == 0) {
        unsigned* bar = b.bar;
        __builtin_amdgcn_s_waitcnt(0);
        unsigned nloc = b.st[0], nx = b.st[1];
        if (nloc == 0u) { xcd_barrier_complete(bar, b.x, nloc, nx); b.st[0] = nloc; b.st[1] = nx; }
        const unsigned old = xb_add(&bar[XB_XSUB(b.x)], 1u);
        const unsigned gen = old / nloc;
        if (old + 1u == (gen + 1u) * nloc) {
            __builtin_amdgcn_fence(__ATOMIC_RELEASE, "agent");
            asm volatile("s_waitcnt vmcnt(0)" ::: "memory");
            const unsigned og = xb_add(&bar[XB_TOP], 1u);
            const unsigned tg = og / nx;
            if (og + 1u == (tg + 1u) * nx) xb_add(&bar[XB_TOPGEN], 1u);
            else XB_SPIN(xb_ld(&bar[XB_TOPGEN]) == tg, bar);
            __builtin_amdgcn_fence(__ATOMIC_ACQUIRE, "agent");
            xb_add(&bar[XB_XGEN(b.x)], 1u);
            asm volatile("s_waitcnt vmcnt(0)" ::: "memory");
        } else {
            XB_SPIN(xb_ld(&bar[XB_XGEN(b.x)]) == gen, bar);
            __builtin_amdgcn_fence(__ATOMIC_ACQUIRE, "agent");
            asm volatile("s_waitcnt vmcnt(0)" ::: "memory");
        }
    }
    __syncthreads();
}

constexpr int PH_PER_LAYER = 20, N_PHASES = 2 * PH_PER_LAYER;
__global__ void __launch_bounds__(NT, 2) mk_fwd(Args a_in) {
    extern __shared__ __attribute__((aligned(16))) unsigned char lds_raw[];
    LAS unsigned char* lds = (LAS unsigned char*)lds_raw;
    const Args& a0 = a_in;
    if (threadIdx.x < 23) ((const float**)(a0.ws + WS_PTRS))[threadIdx.x] = a0.in[threadIdx.x];
    volatile LAS unsigned* xst = (volatile LAS unsigned*)(lds + LDS_BYTES - 32);
    if (threadIdx.x < 4) xst[threadIdx.x] = 0u;
    __syncthreads();
    XcdBarrier xbar; xbar.bar = (unsigned*)(a0.ws + WS_BAR); xbar.x = 0; xbar.st = xst;
    if (a0.ph_hi - a0.ph_lo > 1) xbar = xcd_barrier_post((unsigned*)(a0.ws + WS_BAR), xst);
    if (a0.ph_lo < 0) cg::this_grid().sync();
    for (int p = a0.ph_lo; p < a0.ph_hi; ++p) {
        Ctx a;
        { size_t z_ = 0; asm volatile("" : "+s"(z_)); a.ws = a0.ws + z_; a.out = a0.out + z_; }
        a.in_ = (const float* const*)(a.ws + WS_PTRS);
        const int l = p / PH_PER_LAYER, q = p % PH_PER_LAYER;
        const int kind = (q >= 3 && q <= 14) ? 3 + (q - 3) % 6 : (q == 18 ? 1 : q);
        const int nrep = (kind == REP_Q) ? 2 : 1;
        for (int rep = 0; rep < nrep; ++rep) {
        if (rep) xcd_barrier(xbar);
        if (q == 0) phase_convert(a, l, lds);
        else if (q == 1 || q == 18) phase_ffn1(a, (const bf16_t*)(a.ws + (q == 1 ? W_FFA_IN : W_FFB_IN)), lds);
        else if (q == 2 || q == 17 || q == 19) {
            const bf16_t* A_ = (const bf16_t*)(a.ws + (q == 17 ? B_MERGED : B_ACT));
            const int K_ = (q == 17) ? DM : FF;
            const bf16_t* W_ = (const bf16_t*)(a.ws + (q == 2 ? W_FFA_OUT : (q == 17 ? W_OUT : W_FFB_OUT)));
            const float* xs_ = (q == 2 && l == 0) ? a.in(I_X) : a.out;
            phase_resid_gemm(a, A_, K_, W_, xs_, q == 17 ? 1.0f : 0.5f, lds);
        }
        else if (q >= 3 && q <= 14) {
            const int b = (q - 3) / 6, s = (q - 3) % 6;
            if (s == 0) phase_proj(a, b, lds);
            else if (s == 1) {
                for (int it = fresh_bid(); it < 512; it += gridDim.x) gdn_intra_item(a, l, it & 3, it >> 2, lds);
                phase_post1(a, l, lds);
            }
            else if (s == 2) { phase_mlaup(a, lds); kmean_items(a, lds); }
            else if (s == 3) {
                phase_post2(a, l, lds);
                for (int it = fresh_bid(); it < 128; it += gridDim.x) moba_gate_item(a, it, lds);
            }
            else if (s == 4) phase_mix(a, l, b, lds, rep);
            else phase_gdnpost(a, l, b);
        }
        else if (q == 15) phase_gates(a, lds);
        else phase_merge(a, lds);
        }
        if (p + 1 < a0.ph_hi) { xcd_barrier(xbar); for (int e_ = 0; e_ < EXTRA_SYNC; ++e_) xcd_barrier(xbar); }
    }
}

extern "C" void kernel_launch(void* const* d_in, const int* in_sizes, int n_in, void* d_out, int out_size, void* d_ws, size_t ws_size, hipStream_t stream) {
    static int grid = 0;
    if (grid == 0) {
        if (n_in != 23 || ws_size < WS_NEED) { fprintf(stderr, "kernel_launch: n_in %d ws %zu need %zu\n", n_in, ws_size, (size_t)WS_NEED); grid = -1; return; }
        int dev = 0, cus = 0, per_cu = 0;
        hipGetDevice(&dev);
        hipDeviceGetAttribute(&cus, hipDeviceAttributeMultiprocessorCount, dev);
        if (hipFuncSetAttribute((const void*)mk_fwd, hipFuncAttributeMaxDynamicSharedMemorySize, LDS_BYTES) != hipSuccess) { fprintf(stderr, "kernel_launch: hipFuncSetAttribute failed\n"); grid = -1; return; }
        hipOccupancyMaxActiveBlocksPerMultiprocessor(&per_cu, (const void*)mk_fwd, NT, LDS_BYTES);
        (void)hipGetLastError();
        if (per_cu < 1) per_cu = 1;
        grid = cus * 1;
    }
    if (grid < 0) return;
    Args a{};
    for (int i = 0; i < 23; ++i) a.in[i] = (const float*)d_in[i];
    a.out = (float*)d_out; a.ws = (unsigned char*)d_ws;
#if ONE_LAUNCH
    (void)hipMemsetAsync((unsigned char*)d_ws + WS_BAR, 0, WS_BAR_BYTES, stream);
    a.ph_lo = 0; a.ph_hi = N_PHASES;
    void* args[] = {&a};
    hipError_t e = hipLaunchCooperativeKernel((const void*)mk_fwd, dim3(grid), dim3(NT), args, LDS_BYTES, stream);
    if (e != hipSuccess) fprintf(stderr, "cooperative launch failed: %s (grid %d)\n", hipGetErrorString(e), grid);
#else
    for (int p = 0; p < N_PHASES; ++p) {
        a.ph_lo = p; a.ph_hi = p + 1;
        mk_fwd<<<dim3(grid), dim3(NT), LDS_BYTES, stream>>>(a);
    }
#endif
}
```
